# Optimizing an MI355X kernel written in HIP

```python
import math
import jax, jax.numpy as jnp
from jax import lax
import numpy as np

D_MODEL = 1024
BATCH = 8
SEQ = 4096
DEPTH = 1
DEC_BATCH = 8
DEC_SEQ = 16
PAST_LEN = 4096

CHUNK = 64
EPS = 1e-6
GLA_HEADS = 4
GLA_QK = D_MODEL // 2
GLA_V = D_MODEL
GLA_DK = GLA_QK // GLA_HEADS
GLA_DV = GLA_V // GLA_HEADS
GLA_RANK = 16
GLA_GATE_NORM = 16.0
GDN_HEADS = 8
GDN_DK = 128
GDN_DV = 128
GDN_QK = GDN_HEADS * GDN_DK
GDN_V = GDN_HEADS * GDN_DV
GDN_CONV_CH = 2 * GDN_QK + GDN_V
CONV_W = 4
SPLIT_SIZES = (GLA_QK, GLA_QK, GLA_V, GLA_V, GLA_RANK, GDN_CONV_CH, GDN_V, GDN_HEADS, GDN_HEADS, D_MODEL, D_MODEL)
D_IN = 2 * GLA_QK + 2 * GLA_V + GLA_RANK + GDN_CONV_CH + GDN_V + 2 * GDN_HEADS + 2 * D_MODEL

kernel_name = "gla_gdn_parallel_streaming_step"


def rmsnorm(x, gain):
    xf = x.astype(jnp.float32)
    y = xf * lax.rsqrt(jnp.mean(xf * xf, axis=-1, keepdims=True) + EPS)
    return (y * gain.astype(jnp.float32)).astype(x.dtype)


def l2norm(x):
    return x * lax.rsqrt(jnp.sum(x * x, axis=-1, keepdims=True) + EPS)


def pad_time(a, pad):
    return jnp.pad(a, [(0, 0), (0, pad)] + [(0, 0)] * (a.ndim - 2))


def to_blocks(a):
    b, t = a.shape[0], a.shape[1]
    a = a.reshape((b, t // CHUNK, CHUNK) + a.shape[2:])
    return jnp.moveaxis(a, 2, 3)


def from_blocks(a):
    a = jnp.moveaxis(a, 3, 2)
    return a.reshape((a.shape[0], a.shape[1] * CHUNK) + a.shape[3:])


def gla_chunked(q, k, v, g, s0):
    qc, kc, vc, gc = (to_blocks(a) for a in (q, k, v, g))
    b = jnp.cumsum(gc, axis=3)
    b_ref = b[:, :, :, CHUNK // 2 - 1:CHUNK // 2, :]
    b_last = b[:, :, :, CHUNK - 1:, :]
    incl = jnp.tril(jnp.ones((CHUNK, CHUNK), dtype=bool))
    att = jnp.einsum('bnhid,bnhjd->bnhij', qc * jnp.exp(b - b_ref), kc * jnp.exp(b_ref - b))
    att = jnp.where(incl, att, 0.0)
    o_intra = jnp.einsum('bnhij,bnhjv->bnhiv', att, vc)
    q_dec = qc * jnp.exp(b)
    k_dec = kc * jnp.exp(b_last - b)
    block_decay = jnp.exp(b_last[:, :, :, 0, :])

    def step(s, inp):
        q_n, k_n, v_n, d_n = inp
        o_n = jnp.einsum('bhid,bhdv->bhiv', q_n, s)
        s = d_n[..., None] * s + jnp.einsum('bhjd,bhjv->bhdv', k_n, v_n)
        return s, o_n

    xs = tuple(jnp.moveaxis(a, 1, 0) for a in (q_dec, k_dec, vc, block_decay))
    s_fin, o_inter = lax.scan(step, s0, xs)
    o = o_intra + jnp.moveaxis(o_inter, 0, 1)
    return from_blocks(o), s_fin


def gdn_chunked(q, k, v, beta, g, s0):
    dv = v.shape[-1]
    qc, kc, vc, bc, gc = (to_blocks(a) for a in (q, k, v, beta, g))
    b = jnp.cumsum(gc, axis=-1)
    incl = jnp.tril(jnp.ones((CHUNK, CHUNK), dtype=bool))
    strict = jnp.tril(jnp.ones((CHUNK, CHUNK), dtype=bool), -1)
    diff = b[..., :, None] - b[..., None, :]
    decay_mat = jnp.where(incl, jnp.exp(jnp.where(incl, diff, 0.0)), 0.0)
    kk = jnp.einsum('bnhid,bnhjd->bnhij', kc, kc)
    a_low = jnp.where(strict, bc[..., :, None] * kk * decay_mat, 0.0)
    eye = jnp.eye(CHUNK, dtype=a_low.dtype)
    rhs = jnp.concatenate([bc[..., None] * vc, (bc * jnp.exp(b))[..., None] * kc], axis=-1)
    sol = lax.linalg.triangular_solve(a_low + eye, rhs, left_side=True, lower=True, unit_diagonal=True)
    u_v, w_k = sol[..., :dv], sol[..., dv:]
    qk = jnp.einsum('bnhid,bnhjd->bnhij', qc, kc) * decay_mat
    q_dec = qc * jnp.exp(b)[..., None]
    k_dec = kc * jnp.exp(b[..., -1:] - b)[..., None]
    block_decay = jnp.exp(b[..., -1])

    def step(s, inp):
        q_n, k_n, uv_n, wk_n, qk_n, d_n = inp
        u = uv_n - jnp.einsum('bhid,bhdv->bhiv', wk_n, s)
        o_n = jnp.einsum('bhid,bhdv->bhiv', q_n, s) + jnp.einsum('bhij,bhjv->bhiv', qk_n, u)
        s = d_n[..., None, None] * s + jnp.einsum('bhjd,bhjv->bhdv', k_n, u)
        return s, o_n

    xs = tuple(jnp.moveaxis(a, 1, 0) for a in (q_dec, k_dec, u_v, w_k, qk, block_decay))
    s_fin, o = lax.scan(step, s0, xs)
    return from_blocks(jnp.moveaxis(o, 0, 1)), s_fin


def causal_conv(u, buf, w):
    t = u.shape[1]
    up = jnp.concatenate([buf, u], axis=1)
    y = up[:, 0:t] * w[0]
    for i in range(1, CONV_W):
        y = y + up[:, i:i + t] * w[i]
    return jax.nn.silu(y), up[:, t:]


def head_gated_norm(o, gain, z):
    of = o.astype(jnp.float32)
    of = of * lax.rsqrt(jnp.mean(of * of, axis=-1, keepdims=True) + EPS) * gain.astype(jnp.float32)
    return of * jax.nn.silu(z)


def streaming_layer(x, c, s_gla, s_gdn, conv_buf, w_ada, b_ada, g_norm1, w_in, w_gk2, b_gk,
                    w_conv, a_log, dt_bias, g_norm_a, g_norm_b, w_pa, w_pb, w_out):
    bsz, t, _ = x.shape
    pad = (-t) % CHUNK
    f32 = jnp.float32
    mod = jax.nn.silu(c) @ w_ada + b_ada
    shift, scale, gate = jnp.split(mod, 3, axis=-1)
    h = rmsnorm(x, g_norm1) * (1.0 + scale[:, None, :]) + shift[:, None, :]
    p = (h @ w_in).astype(f32)
    split_idx = [int(i) for i in np.cumsum(SPLIT_SIZES)[:-1]]
    qa, ka, va, za, gk_low, qkv_b, zb, beta_in, a_in, ga, gb = jnp.split(p, split_idx, axis=-1)

    gk = jax.nn.log_sigmoid(gk_low @ w_gk2 + b_gk) / GLA_GATE_NORM
    qa = qa.reshape(bsz, t, GLA_HEADS, GLA_DK) * (GLA_DK ** -0.5)
    ka = ka.reshape(bsz, t, GLA_HEADS, GLA_DK)
    va = va.reshape(bsz, t, GLA_HEADS, GLA_DV)
    gk = gk.reshape(bsz, t, GLA_HEADS, GLA_DK)
    oa, s_gla_new = gla_chunked(pad_time(qa, pad), pad_time(ka, pad), pad_time(va, pad),
                                pad_time(gk, pad), s_gla.astype(f32))
    oa = head_gated_norm(oa[:, :t], g_norm_a, za.reshape(bsz, t, GLA_HEADS, GLA_DV))
    oa = oa.reshape(bsz, t, GLA_V)

    qkv_c, conv_new = causal_conv(qkv_b, conv_buf.astype(f32), w_conv)
    qb, kb, vb = jnp.split(qkv_c, [GDN_QK, 2 * GDN_QK], axis=-1)
    qb = l2norm(qb.reshape(bsz, t, GDN_HEADS, GDN_DK)) * (GDN_DK ** -0.5)
    kb = l2norm(kb.reshape(bsz, t, GDN_HEADS, GDN_DK))
    vb = vb.reshape(bsz, t, GDN_HEADS, GDN_DV)
    beta = jax.nn.sigmoid(beta_in)
    g_b = -jnp.exp(a_log.astype(f32)) * jax.nn.softplus(a_in + dt_bias)
    ob, s_gdn_new = gdn_chunked(pad_time(qb, pad), pad_time(kb, pad), pad_time(vb, pad),
                                pad_time(beta, pad), pad_time(g_b, pad), s_gdn.astype(f32))
    ob = head_gated_norm(ob[:, :t], g_norm_b, zb.reshape(bsz, t, GDN_HEADS, GDN_DV))
    ob = ob.reshape(bsz, t, GDN_V)

    merged = jax.nn.sigmoid(ga) * (oa @ w_pa) + jax.nn.sigmoid(gb) * (ob @ w_pb)
    out = (merged @ w_out).astype(x.dtype)
    x = x + gate[:, None, :] * out
    return x, s_gla_new.astype(s_gla.dtype), s_gdn_new.astype(s_gdn.dtype), conv_new.astype(conv_buf.dtype)


def setup_inputs(seed: int = 0) -> dict:
    key = jax.random.key(seed)
    ks = jax.random.split(key, 24)

    def nrm(k, shape, s):
        return jax.random.normal(k, shape, jnp.float32) * s

    dt = jnp.exp(jax.random.uniform(ks[15], (DEPTH, GDN_HEADS), jnp.float32, math.log(1e-3), math.log(1e-1)))
    return {
        "x_prompt": nrm(ks[0], (BATCH, SEQ, D_MODEL), 1.0),
        "x_sample": nrm(ks[1], (DEC_BATCH, DEC_SEQ, D_MODEL), 1.0),
        "c_prompt": nrm(ks[2], (BATCH, D_MODEL), 1.0),
        "c_sample": nrm(ks[3], (DEC_BATCH, D_MODEL), 1.0),
        "state_gla": nrm(ks[4], (DEPTH, DEC_BATCH, GLA_HEADS, GLA_DK, GLA_DV), 1.0),
        "state_gdn": nrm(ks[5], (DEPTH, DEC_BATCH, GDN_HEADS, GDN_DK, GDN_DV), 0.3),
        "cache_conv_gdn": nrm(ks[6], (DEPTH, DEC_BATCH, CONV_W - 1, GDN_CONV_CH), 1.0),
        "w_ada": nrm(ks[7], (DEPTH, D_MODEL, 3 * D_MODEL), 0.5 * D_MODEL ** -0.5),
        "b_ada": nrm(ks[8], (DEPTH, 3 * D_MODEL), 0.02),
        "g_norm1": 1.0 + nrm(ks[9], (DEPTH, D_MODEL), 0.02),
        "w_in": nrm(ks[10], (DEPTH, D_MODEL, D_IN), D_MODEL ** -0.5),
        "w_gk2": nrm(ks[11], (DEPTH, GLA_RANK, GLA_QK), GLA_RANK ** -0.5),
        "b_gk": nrm(ks[12], (DEPTH, GLA_QK), 0.1),
        "w_conv": nrm(ks[13], (DEPTH, CONV_W, GDN_CONV_CH), CONV_W ** -0.5),
        "a_log": jnp.log(jax.random.uniform(ks[14], (DEPTH, GDN_HEADS), jnp.float32, 1.0, 16.0)),
        "dt_bias": dt + jnp.log(-jnp.expm1(-dt)),
        "g_norm_a": 1.0 + nrm(ks[16], (DEPTH, GLA_DV), 0.02),
        "g_norm_b": 1.0 + nrm(ks[17], (DEPTH, GDN_DV), 0.02),
        "w_pa": nrm(ks[18], (DEPTH, GLA_V, D_MODEL), GLA_V ** -0.5),
        "w_pb": nrm(ks[19], (DEPTH, GDN_V, D_MODEL), GDN_V ** -0.5),
        "w_out": nrm(ks[20], (DEPTH, D_MODEL, D_MODEL), D_MODEL ** -0.5),
        "g_final": 1.0 + nrm(ks[21], (D_MODEL,), 0.02),
    }


def reference(x_prompt, x_sample, c_prompt, c_sample, state_gla, state_gdn, cache_conv_gdn,
              w_ada, b_ada, g_norm1, w_in, w_gk2, b_gk, w_conv, a_log, dt_bias,
              g_norm_a, g_norm_b, w_pa, w_pb, w_out, g_final):
    bp = x_prompt.shape[0]
    hp, hs = x_prompt, x_sample
    gla_p, gdn_p, conv_p, gla_s, gdn_s, conv_s = [], [], [], [], [], []
    for layer in range(DEPTH):
        lw = (w_ada[layer], b_ada[layer], g_norm1[layer], w_in[layer], w_gk2[layer], b_gk[layer],
              w_conv[layer], a_log[layer], dt_bias[layer], g_norm_a[layer], g_norm_b[layer],
              w_pa[layer], w_pb[layer], w_out[layer])
        z_gla = jnp.zeros((bp, GLA_HEADS, GLA_DK, GLA_DV), jnp.float32)
        z_gdn = jnp.zeros((bp, GDN_HEADS, GDN_DK, GDN_DV), jnp.float32)
        z_conv = jnp.zeros((bp, CONV_W - 1, GDN_CONV_CH), jnp.float32)
        hp, sg, sd, cv = streaming_layer(hp, c_prompt, z_gla, z_gdn, z_conv, *lw)
        gla_p.append(sg)
        gdn_p.append(sd)
        conv_p.append(cv)
        hs, sg, sd, cv = streaming_layer(hs, c_sample, state_gla[layer], state_gdn[layer], cache_conv_gdn[layer], *lw)
        gla_s.append(sg)
        gdn_s.append(sd)
        conv_s.append(cv)
    y_prompt = rmsnorm(hp, g_final)
    y_sample = rmsnorm(hs, g_final)
    return (y_prompt, y_sample, jnp.stack(gla_p), jnp.stack(gdn_p), jnp.stack(conv_p), jnp.stack(gla_s), jnp.stack(gdn_s), jnp.stack(conv_s))
```

```cpp
#define PROBE_DUP 0
#include <hip/hip_runtime.h>
#include <hip/hip_cooperative_groups.h>
#include <cstdio>
namespace cg = cooperative_groups;

#define LAS __attribute__((address_space(3)))
#define DI __device__ __forceinline__
typedef unsigned short bf16_t;
typedef short bf16x8 __attribute__((ext_vector_type(8)));
typedef float f32x4 __attribute__((ext_vector_type(4)));
typedef unsigned u32x4 __attribute__((ext_vector_type(4)));
typedef unsigned u32x2 __attribute__((ext_vector_type(2)));
typedef float f32x2 __attribute__((ext_vector_type(2)));

#ifndef N_LAUNCH_PER_PHASE
#define N_LAUNCH_PER_PHASE 0
#endif

constexpr int MP = 32768;
constexpr int MT = 33280;
constexpr int NCH = 520;
constexpr int PLD = 5120;
constexpr int QA = 0, KA = 512, VA = 1024, GQ = 2048, GK = 3072, GV = 4096;
constexpr float EPS = 1e-6f;
#define PADDR(row, col) (((size_t)((col) >> 7) * MT + (size_t)(row)) * 128 + ((col) & 127))
constexpr int PRS = 128;
constexpr int NTHR = 512;
constexpr int LDS_BYTES = 147456;

constexpr size_t al256(size_t x) { return (x + 255) & ~(size_t)255; }
constexpr size_t WS_P    = 0;
constexpr size_t WS_W1   = al256(WS_P + (size_t)MT * PLD * 2);
constexpr size_t WS_WSM  = al256(WS_W1 + (size_t)9216 * 1024 * 2);
constexpr size_t WS_WPA  = al256(WS_WSM + (size_t)32 * 1024 * 2);
constexpr size_t WS_WPB  = WS_WPA + 2097152;
constexpr size_t WS_WOUT = WS_WPB + 2097152;
constexpr size_t WS_MOD  = WS_WOUT + 2097152;
constexpr size_t WS_PS   = al256(WS_MOD + (size_t)16 * 3072 * 4);
constexpr size_t WS_HALO = al256(WS_PS + (size_t)MT * 32 * 4);
constexpr size_t WS_ATT  = al256(WS_HALO + (size_t)NCH * 3 * 3072 * 2);
constexpr size_t WS_GDEC = al256(WS_ATT + (size_t)NCH * 4 * 4096 * 2);
constexpr size_t WS_WK   = al256(WS_GDEC + (size_t)NCH * 4 * 128 * 4);
constexpr size_t WS_QK   = al256(WS_WK + (size_t)NCH * 8 * 8192 * 2);
constexpr size_t WS_BDEC = al256(WS_QK + (size_t)NCH * 8 * 4096 * 2);
constexpr size_t WS_SSA  = al256(WS_BDEC + (size_t)NCH * 8 * 4);
constexpr size_t WS_SSB  = al256(WS_SSA + (size_t)MT * 32 * 4);
constexpr size_t WS_SSY  = al256(WS_SSB + (size_t)MT * 32 * 4);
constexpr size_t WS_SSYS = al256(WS_SSY + (size_t)MT * 16 * 4);
constexpr size_t WS_BAR  = al256(WS_SSYS + (size_t)512 * 32 * 4);
constexpr size_t WS_END  = al256(WS_BAR + (size_t)4096 * 4);

constexpr size_t O_YP = 0, O_YS = 33554432, O_SGLAP = 33685504, O_SGDNP = 34734080, O_CONVP = 35782656,
                 O_SGLAS = 35856384, O_SGDNS = 36904960, O_CONVS = 37953536;

struct Params { const float* in[22]; float* out; unsigned char* ws; int ph_lo, ph_hi; };

typedef __bf16 bf16v2_t __attribute__((ext_vector_type(2)));
DI unsigned cvt_pk_bf16(float lo, float hi) { bf16v2_t v = {(__bf16)lo, (__bf16)hi}; return __builtin_bit_cast(unsigned, v); }
DI unsigned f2bf(float x) { return (unsigned)__builtin_bit_cast(unsigned short, (__bf16)x); }
DI float bf2f(unsigned b) { return __uint_as_float(b << 16); }
DI float bflo(unsigned w) { return __uint_as_float(w << 16); }
DI float bfhi(unsigned w) { return __uint_as_float(w & 0xffff0000u); }
DI float sigmoidf_(float x) { return 1.0f / (1.0f + __expf(-x)); }
DI float siluf_(float x) { return x / (1.0f + __expf(-x)); }
DI float fsilu(float x) { return x * __builtin_amdgcn_rcpf(1.0f + __expf(-x)); }
DI float softplusf_(float x) { return fmaxf(x, 0.f) + log1pf(__expf(-fabsf(x))); }
DI float logsigmoidf_(float x) { return -softplusf_(-x); }
DI int laundered_tid() { int t = threadIdx.x; asm volatile("" : "+v"(t)); return t; }
DI float row16_sum(float x) {
    x += __builtin_bit_cast(float, __builtin_amdgcn_update_dpp(0, __builtin_bit_cast(int, x), 0xB1, 0xF, 0xF, true));
    x += __builtin_bit_cast(float, __builtin_amdgcn_update_dpp(0, __builtin_bit_cast(int, x), 0x4E, 0xF, 0xF, true));
    x += __builtin_bit_cast(float, __builtin_amdgcn_update_dpp(0, __builtin_bit_cast(int, x), 0x141, 0xF, 0xF, true));
    x += __builtin_bit_cast(float, __builtin_amdgcn_update_dpp(0, __builtin_bit_cast(int, x), 0x140, 0xF, 0xF, true));
    return x;
}
#define MFMA16(a, b, c) __builtin_amdgcn_mfma_f32_16x16x32_bf16((a), (b), (c), 0, 0, 0)

DI bf16x8 ldfrag(const LAS bf16_t* base, int ld, int lane, int k) { return *(const LAS bf16x8*)(base + (lane & 15) * ld + (lane >> 4) * 8 + k); }
template <int K>
DI f32x4 mma16(f32x4 acc, const LAS bf16_t* A, int lda, const LAS bf16_t* Bt, int ldb, int lane) {
    const LAS bf16_t* ap = A + (lane & 15) * lda + (lane >> 4) * 8;
    const LAS bf16_t* bp = Bt + (lane & 15) * ldb + (lane >> 4) * 8;
#pragma unroll
    for (int k = 0; k < K; k += 32) acc = MFMA16(*(const LAS bf16x8*)(ap + k), *(const LAS bf16x8*)(bp + k), acc);
    return acc;
}

#define XB_TMO      128
#define XB_XCNT(j)  (256  + 64 * (j))
#define XB_XSUB(j)  (1280 + 64 * (j))
#define XB_XGEN(j)  (2304 + 64 * (j))
#define XB_TOP      3328
#define XB_TOPGEN   3392
#define XCD_BAR_WORDS 3456
#define XB_SPIN_CAP (1u << 18)

__device__ __forceinline__ unsigned xb_ld(unsigned* p)              { return __hip_atomic_load(p, __ATOMIC_RELAXED, __HIP_MEMORY_SCOPE_AGENT); }
__device__ __forceinline__ unsigned xb_add(unsigned* p, unsigned v) { return __hip_atomic_fetch_add(p, v, __ATOMIC_RELAXED, __HIP_MEMORY_SCOPE_AGENT); }
__device__ __forceinline__ unsigned xb_xcc_id() { return (unsigned)__builtin_amdgcn_s_getreg((3 << 11) | 20) & 0xFu; }
#define XB_SPIN(cond, bar) do { unsigned _sp = 0; while (cond) { __builtin_amdgcn_s_sleep(1); \
    if ((++_sp & 255u) == 0u) { if (xb_ld(&(bar)[XB_TMO])) break; if (_sp > XB_SPIN_CAP) { atomicAdd(&(bar)[XB_TMO], 1u); break; } } } } while (0)

struct XcdBarrier {
    unsigned* bar; unsigned x;
    volatile LAS unsigned* st;
};

__device__ __forceinline__ XcdBarrier xcd_barrier_post(unsigned* bar, volatile LAS unsigned* st) {
    XcdBarrier b; b.bar = bar; b.x = xb_xcc_id(); b.st = st;
    if (threadIdx.x == 0) (void)xb_add(&bar[XB_XCNT(b.x)], 1u);
    return b;
}
__device__ __forceinline__ void xcd_barrier_complete(unsigned* bar, unsigned x, unsigned& nloc, unsigned& nx) {
    const unsigned G = gridDim.x * gridDim.y * gridDim.z;
    unsigned sum, cnt, mine, sp = 0u;
    for (;;) {
        sum = 0u; cnt = 0u; mine = 0u;
#pragma unroll
        for (unsigned j = 0; j < 16; ++j) { const unsigned c = xb_ld(&bar[XB_XCNT(j)]); sum += c; cnt += (c > 0u) ? 1u : 0u; mine = (j == x) ? c : mine; }
        if (sum == G) break;
        __builtin_amdgcn_s_sleep(1);
        if ((++sp & 255u) == 0u) { if (xb_ld(&bar[XB_TMO])) break; if (sp > XB_SPIN_CAP) { atomicAdd(&bar[XB_TMO], 1u); break; } }
    }
    nloc = mine > 0u ? mine : 1u; nx = cnt > 0u ? cnt : 1u;
}

__device__ __forceinline__ void xcd_barrier(const XcdBarrier& b) {
    asm volatile("s_waitcnt vmcnt(0)" ::: "memory");
    __syncthreads();
    if (threadIdx.x == 0) {
        unsigned* bar = b.bar;
        __builtin_amdgcn_s_waitcnt(0);
        unsigned nloc = b.st[0], nx = b.st[1];
        if (nloc == 0u) { xcd_barrier_complete(bar, b.x, nloc, nx); b.st[0] = nloc; b.st[1] = nx; }
        const unsigned old = xb_add(&bar[XB_XSUB(b.x)], 1u);
        const unsigned gen = old / nloc;
        if (old + 1u == (gen + 1u) * nloc) {
            __builtin_amdgcn_fence(__ATOMIC_RELEASE, "agent");
            asm volatile("s_waitcnt vmcnt(0)" ::: "memory");
            const unsigned og = xb_add(&bar[XB_TOP], 1u);
            const unsigned tg = og / nx;
            if (og + 1u == (tg + 1u) * nx) xb_add(&bar[XB_TOPGEN], 1u);
            else XB_SPIN(xb_ld(&bar[XB_TOPGEN]) == tg, bar);
            __builtin_amdgcn_fence(__ATOMIC_ACQUIRE, "agent");
            xb_add(&bar[XB_XGEN(b.x)], 1u);
            asm volatile("s_waitcnt vmcnt(0)" ::: "memory");
        } else {
            XB_SPIN(xb_ld(&bar[XB_XGEN(b.x)]) == gen, bar);
            __builtin_amdgcn_fence(__ATOMIC_ACQUIRE, "agent");
            asm volatile("s_waitcnt vmcnt(0)" ::: "memory");
        }
    }
    __syncthreads();
}


namespace pg8 {
constexpr int BM = 256, BK = 64, HALF = 128, HTB = HALF * BK * 2, STAGE_BYTES = 8 * HTB, NXCD = 8, WGM = 8;
DI int lds_byte(int r, int c) { const int st = (r >> 4) * 2 + (c >> 5), rr = r & 15, cc = c & 31, ob = rr * 64 + cc * 2; return st * 1024 + (ob ^ (((ob >> 9) & 1) << 5)); }
DI void stage_rc(int b, int& R, int& C) { const int st = b / 1024, sb = b % 1024, swz = sb ^ (((sb >> 9) & 1) << 5); R = (st >> 1) * 16 + swz / 64; C = (st & 1) * 32 + (swz % 64) / 2; }
DI int perm32(int rho) { const int n = rho >> 4, i = rho & 15; return 8 * (i >> 2) + 4 * n + (i & 3); }
struct Unit { int pm, pn; };
struct Gemm { const bf16_t* A; const bf16_t* Bt; int M, N, K, lda; size_t wstepA; };
struct StaticOrder {
    int nM, nN, nwg, G, c;
    DI void init(int M, int N, int G_, int c_) { nM = M / BM; nN = N / BM; nwg = nM * nN; G = G_; c = c_; }
    DI bool next(int i, Unit& u) const {
        const long L = (long)i * G + c; if (L >= nwg) return false;
        int wgid = (int)L; { const int q = nwg / NXCD, r = nwg % NXCD, xcd = wgid % NXCD, off = wgid / NXCD; wgid = (xcd < r ? xcd * (q + 1) : r * (q + 1) + (xcd - r) * q) + off; }
        const int nig = WGM * nN, gid = wgid / nig, fm = gid * WGM, gsz = (nM - fm) < WGM ? (nM - fm) : WGM;
        u.pm = fm + ((wgid % nig) % gsz); u.pn = (wgid % nig) / gsz; return true;
    }
};

template <class Epi>
DI void gemm_phase(LAS unsigned char* lds, const Gemm g, const StaticOrder& S, const Epi& E) {
    const int tid = laundered_tid(), wid = __builtin_amdgcn_readfirstlane(tid >> 6), lane = tid & 63, wr = wid >> 2, wc = wid & 3, fr = lane & 15, fq = lane >> 4;
    const int K = g.K, nt = K / BK, lda = g.lda;
    unsigned voffA[2], voffB[2];
#pragma unroll
    for (int i = 0; i < 2; ++i) { int R, C; stage_rc(tid * 16 + i * 8192, R, C); const int Rb = Epi::PERM ? ((R & ~31) + perm32(R & 31)) : R;
        voffA[i] = (unsigned)(R * lda + C) * 2u; voffB[i] = (unsigned)(Rb * K + C) * 2u; }
    const size_t kstep = (size_t)(BK * 2);
    const size_t hstepA = (size_t)HALF * lda * 2, hstepB = (size_t)HALF * K * 2;
    const size_t tstepA = 2 * hstepA, tstepB = 2 * hstepB;
    const unsigned ldsw = (unsigned)wid * 1024u;
    const int aoff = lds_byte(wr * 64 + fr, fq * 8), boff = lds_byte(wc * 32 + fr, fq * 8);
#define PG8_SA(b, h) (((b) * 2 + (h)) * HTB)
#define PG8_SB(b, h) ((4 + (b) * 2 + (h)) * HTB)
#define PG8_STAGE(bufoff, gbase, voff) do { _Pragma("unroll") for (int _i = 0; _i < 2; ++_i) \
        __builtin_amdgcn_global_load_lds((const unsigned*)((const char*)(gbase) + (voff)[_i]), (LAS unsigned*)(lds + (bufoff) + ldsw + _i * 8192), 16, 0, 0); } while (0)
#define PG8_LDA(dst, b, h) do { _Pragma("unroll") for (int m = 0; m < 4; ++m) _Pragma("unroll") for (int k = 0; k < 2; ++k) dst[m][k] = *(const LAS bf16x8*)(lds + PG8_SA(b, h) + aoff + m * 2048 + k * 1024); } while (0)
#define PG8_LDB(dst, b, h) do { _Pragma("unroll") for (int n = 0; n < 2; ++n) _Pragma("unroll") for (int k = 0; k < 2; ++k) dst[n][k] = *(const LAS bf16x8*)(lds + PG8_SB(b, h) + boff + n * 2048 + k * 1024); } while (0)
#define PG8_MMA(ai, bj, At, Bt) do { __builtin_amdgcn_s_setprio(1); _Pragma("unroll") for (int m = 0; m < 4; ++m) _Pragma("unroll") for (int n = 0; n < 2; ++n) _Pragma("unroll") for (int k = 0; k < 2; ++k) \
        acc[ai][bj][m][n] = __builtin_amdgcn_mfma_f32_16x16x32_bf16(Bt[n][k], At[m][k], acc[ai][bj][m][n], 0, 0, 0); __builtin_amdgcn_s_setprio(0); } while (0)
#define PG8_WAIT_V(n) asm volatile("s_waitcnt vmcnt(" #n ")" ::: "memory")
#define PG8_WAIT_L(n) asm volatile("s_waitcnt lgkmcnt(" #n ")" ::: "memory")
#define PG8_BAR __builtin_amdgcn_s_barrier()
#define PG8_SCHED __builtin_amdgcn_sched_barrier(0)
    Unit cur, nxt; int ui = 0;
    if (!S.next(0, cur)) return;
    f32x4 acc[2][2][4][2];
#pragma unroll
    for (int a = 0; a < 2; ++a)
#pragma unroll
        for (int b = 0; b < 2; ++b)
#pragma unroll
            for (int m = 0; m < 4; ++m)
#pragma unroll
                for (int n = 0; n < 2; ++n) acc[a][b][m][n] = (f32x4){0.f, 0.f, 0.f, 0.f};
    bf16x8 At[4][2], B0[2][2], B1[2][2];
    const char* cA = (const char*)g.A + (size_t)cur.pm * tstepA; const char* cB = (const char*)g.Bt + (size_t)cur.pn * tstepB;
    PG8_STAGE(PG8_SB(0, 0), cB, voffB); PG8_STAGE(PG8_SA(0, 0), cA, voffA); PG8_STAGE(PG8_SB(0, 1), cB + hstepB, voffB); PG8_STAGE(PG8_SA(0, 1), cA + hstepA, voffA);
    if (wr == 1) PG8_BAR;
    PG8_WAIT_V(4); PG8_BAR;
    PG8_STAGE(PG8_SB(1, 0), cB + kstep, voffB); PG8_STAGE(PG8_SA(1, 0), cA + kstep, voffA); PG8_STAGE(PG8_SB(1, 1), cB + hstepB + kstep, voffB);
    PG8_WAIT_V(6); PG8_BAR;
    for (;;) {
        const bool has_next = S.next(ui + 1, nxt);
        const char* nA = has_next ? (const char*)g.A + (size_t)nxt.pm * tstepA : cA; const char* nB = has_next ? (const char*)g.Bt + (size_t)nxt.pn * tstepB : cB;
        for (int t = 0; t < nt; t += 2) {
            const bool last = (t == nt - 2);
            const char* aT = cA + (size_t)(t >> 1) * g.wstepA;
            const char* a1 = aT + kstep;
            const char* a2 = last ? nA : aT + g.wstepA; const char* b2 = last ? nB : cB + (size_t)(t + 2) * kstep;
            const char* a3 = a2 + kstep; const char* b3 = b2 + kstep;
            PG8_LDB(B0, 0, 0); PG8_SCHED; PG8_LDA(At, 0, 0); PG8_STAGE(PG8_SA(1, 1), a1 + hstepA, voffA);
            PG8_WAIT_L(8); PG8_BAR; PG8_WAIT_L(0); PG8_MMA(0, 0, At, B0); PG8_BAR; PG8_SCHED;
            PG8_LDB(B1, 0, 1); PG8_STAGE(PG8_SB(0, 0), b2, voffB);
            PG8_BAR; PG8_WAIT_L(0); PG8_MMA(0, 1, At, B1); PG8_BAR;
            PG8_LDA(At, 0, 1); PG8_STAGE(PG8_SA(0, 0), a2, voffA);
            PG8_BAR; PG8_WAIT_L(0); PG8_MMA(1, 0, At, B0); PG8_BAR; PG8_SCHED;
            PG8_STAGE(PG8_SB(0, 1), b2 + hstepB, voffB);
            PG8_WAIT_V(6); PG8_BAR; PG8_MMA(1, 1, At, B1); PG8_BAR;
            PG8_LDB(B0, 1, 0); PG8_SCHED; PG8_LDA(At, 1, 0); PG8_STAGE(PG8_SA(0, 1), a2 + hstepA, voffA);
            PG8_WAIT_L(8); PG8_BAR; PG8_WAIT_L(0); PG8_MMA(0, 0, At, B0); PG8_BAR; PG8_SCHED;
            PG8_LDB(B1, 1, 1); PG8_STAGE(PG8_SB(1, 0), b3, voffB);
            PG8_BAR; PG8_WAIT_L(0); PG8_MMA(0, 1, At, B1); PG8_BAR;
            PG8_LDA(At, 1, 1); PG8_STAGE(PG8_SA(1, 0), a3, voffA);
            PG8_BAR; PG8_WAIT_L(0); PG8_MMA(1, 0, At, B0); PG8_BAR; PG8_SCHED;
            PG8_STAGE(PG8_SB(1, 1), b3 + hstepB, voffB);
            PG8_WAIT_V(6); PG8_BAR; PG8_MMA(1, 1, At, B1); PG8_BAR;
        }
        E(acc, cur, wr, wc, fr, fq);
        if (!has_next) break;
#pragma unroll
        for (int a = 0; a < 2; ++a)
#pragma unroll
            for (int b = 0; b < 2; ++b)
#pragma unroll
                for (int m = 0; m < 4; ++m)
#pragma unroll
                    for (int n = 0; n < 2; ++n) acc[a][b][m][n] = (f32x4){0.f, 0.f, 0.f, 0.f};
        cur = nxt; cA = nA; cB = nB; ++ui;
    }
    PG8_WAIT_V(0);
    if (wr == 0) PG8_BAR;
    PG8_BAR;
#undef PG8_SA
#undef PG8_SB
#undef PG8_STAGE
#undef PG8_LDA
#undef PG8_LDB
#undef PG8_MMA
#undef PG8_WAIT_V
#undef PG8_WAIT_L
#undef PG8_BAR
#undef PG8_SCHED
}
}
using pg8::Unit;
typedef f32x4 AccT[2][2][4][2];

struct EpiG1 {
    static constexpr bool PERM = true;
    bf16_t* P; bf16_t* halo; float* convp; float* convs;
    DI void operator()(const AccT& acc, const Unit& u, int wr, int wc, int fr, int fq) const {
        const int row0 = u.pm * 256 + wr * 64 + fr, col0 = u.pn * 256 + wc * 32 + 8 * fq;
#pragma unroll
        for (int ai = 0; ai < 2; ++ai)
#pragma unroll
            for (int m = 0; m < 4; ++m) {
                const int row = row0 + ai * 128 + m * 16;
#pragma unroll
                for (int bj = 0; bj < 2; ++bj) {
                    const int col = col0 + bj * 128;
                    const f32x4 v0 = acc[ai][bj][m][0], v1 = acc[ai][bj][m][1];
                    u32x4 w; w.x = cvt_pk_bf16(v0[0], v0[1]); w.y = cvt_pk_bf16(v0[2], v0[3]); w.z = cvt_pk_bf16(v1[0], v1[1]); w.w = cvt_pk_bf16(v1[2], v1[3]);
                    __builtin_nontemporal_store(w, (u32x4*)(P + PADDR(row, col)));
                    if (u.pn >= 8) {
                        const int gcol = col - 2048, rl = row & 63;
                        if (rl >= 61) *(u32x4*)(halo + ((size_t)(row >> 6) * 3 + (rl - 61)) * 3072 + gcol) = w;
                        float* dst = nullptr;
                        if (row < MP) { if ((row & 4095) >= 4093) dst = convp + ((size_t)(row >> 12) * 3 + ((row & 4095) - 4093)) * 3072 + gcol; }
                        else if (rl >= 13 && rl < 16) dst = convs + ((size_t)((row - MP) >> 6) * 3 + (rl - 13)) * 3072 + gcol;
                        if (dst) { *(f32x4*)dst = v0; *(f32x4*)(dst + 4) = v1; }
                    }
                }
            }
    }
};
struct EpiG1b {
    static constexpr bool PERM = true;
    bf16_t* P; const float* ssa; const float* ssb; const float* gna; const float* gnb; bool dry;
    DI void operator()(const AccT& acc, const Unit& u, int wr, int wc, int fr, int fq) const {
        const int row0 = u.pm * 256 + wr * 64 + fr, ct0 = wc * 32 + 8 * fq;
        const int kind = u.pn >> 2, sub = u.pn & 3;
        float gg[2][8];
#pragma unroll
        for (int bj = 0; bj < 2; ++bj) { const int ct = ct0 + bj * 128; const float* gn = kind == 0 ? gna + ct : gnb + (ct & 127);
            const f32x4 g0 = kind <= 1 ? *(const f32x4*)gn : (f32x4){0.f, 0.f, 0.f, 0.f}, g1 = kind <= 1 ? *(const f32x4*)(gn + 4) : (f32x4){0.f, 0.f, 0.f, 0.f};
            gg[bj][0] = g0[0]; gg[bj][1] = g0[1]; gg[bj][2] = g0[2]; gg[bj][3] = g0[3]; gg[bj][4] = g1[0]; gg[bj][5] = g1[1]; gg[bj][6] = g1[2]; gg[bj][7] = g1[3]; }
#pragma unroll
        for (int ai = 0; ai < 2; ++ai)
#pragma unroll
            for (int m = 0; m < 4; ++m) {
                const int row = row0 + ai * 128 + m * 16;
                float rstdA = 0.f;
                if (kind == 0) { const f32x4 s0 = *(const f32x4*)(ssa + (size_t)row * 32 + sub * 8), s1 = *(const f32x4*)(ssa + (size_t)row * 32 + sub * 8 + 4);
                    rstdA = rsqrtf(((s0[0] + s0[1]) + (s0[2] + s0[3]) + (s1[0] + s1[1]) + (s1[2] + s1[3])) * (1.0f / 256.0f) + EPS); }
#pragma unroll
                for (int bj = 0; bj < 2; ++bj) {
                    const int ct = ct0 + bj * 128;
                    const f32x4 v0 = acc[ai][bj][m][0], v1 = acc[ai][bj][m][1];
                    float z[8] = {v0[0], v0[1], v0[2], v0[3], v1[0], v1[1], v1[2], v1[3]};
                    float o[8];
                    bf16_t* dst;
                    if (kind <= 1) {
                        float rstd;
                        if (kind == 0) { dst = P + PADDR(row, VA + sub * 256 + ct); rstd = rstdA; }
                        else { dst = P + PADDR(row, GV + sub * 256 + ct); const int head = sub * 2 + bj;
                            const f32x4 s0 = *(const f32x4*)(ssb + (size_t)row * 32 + head * 4);
                            rstd = rsqrtf(((s0[0] + s0[1]) + (s0[2] + s0[3])) * (1.0f / 128.0f) + EPS); }
                        const u32x4 ov = *(const u32x4*)dst;
                        const float of[8] = {bflo(ov.x), bfhi(ov.x), bflo(ov.y), bfhi(ov.y), bflo(ov.z), bfhi(ov.z), bflo(ov.w), bfhi(ov.w)};
#pragma unroll
                        for (int e = 0; e < 8; ++e) o[e] = of[e] * rstd * gg[bj][e] * fsilu(z[e]);
                    } else {
                        dst = P + PADDR(row, (kind == 2 ? QA : GQ) + sub * 256 + ct);
#pragma unroll
                        for (int e = 0; e < 8; ++e) o[e] = __builtin_amdgcn_rcpf(1.0f + __expf(-z[e]));
                    }
                    u32x4 w; w.x = cvt_pk_bf16(o[0], o[1]); w.y = cvt_pk_bf16(o[2], o[3]); w.z = cvt_pk_bf16(o[4], o[5]); w.w = cvt_pk_bf16(o[6], o[7]);
                    if (!dry) *(u32x4*)dst = w;
                }
            }
    }
};
template <int SECOND>
struct EpiMerge {
    static constexpr bool PERM = true;
    bf16_t* P; bool dry;
    DI void operator()(const AccT& acc, const Unit& u, int wr, int wc, int fr, int fq) const {
        const int row0 = u.pm * 256 + wr * 64 + fr, col0 = u.pn * 256 + wc * 32 + 8 * fq;
#pragma unroll
        for (int ai = 0; ai < 2; ++ai)
#pragma unroll
            for (int m = 0; m < 4; ++m) {
                const int row = row0 + ai * 128 + m * 16;
#pragma unroll
                for (int bj = 0; bj < 2; ++bj) {
                    const int col = col0 + bj * 128;
                    const f32x4 v0 = acc[ai][bj][m][0], v1 = acc[ai][bj][m][1];
                    const float z[8] = {v0[0], v0[1], v0[2], v0[3], v1[0], v1[1], v1[2], v1[3]};
                    const u32x4 sg = *(const u32x4*)(P + PADDR(row, (SECOND ? GQ : QA) + col));
                    const float sf[8] = {bflo(sg.x), bfhi(sg.x), bflo(sg.y), bfhi(sg.y), bflo(sg.z), bfhi(sg.z), bflo(sg.w), bfhi(sg.w)};
                    bf16_t* dst = P + PADDR(row, GK + col);
                    float o[8];
                    if (SECOND) { const u32x4 tv = *(const u32x4*)dst;
                        const float tf[8] = {bflo(tv.x), bfhi(tv.x), bflo(tv.y), bfhi(tv.y), bflo(tv.z), bfhi(tv.z), bflo(tv.w), bfhi(tv.w)};
#pragma unroll
                        for (int e = 0; e < 8; ++e) o[e] = tf[e] + sf[e] * z[e];
                    } else {
#pragma unroll
                        for (int e = 0; e < 8; ++e) o[e] = sf[e] * z[e];
                    }
                    u32x4 w; w.x = cvt_pk_bf16(o[0], o[1]); w.y = cvt_pk_bf16(o[2], o[3]); w.z = cvt_pk_bf16(o[4], o[5]); w.w = cvt_pk_bf16(o[6], o[7]);
                    if (!dry) *(u32x4*)dst = w;
                }
            }
    }
};
struct EpiOut {
    static constexpr bool PERM = true;
    bf16_t* P;
    DI void operator()(const AccT& acc, const Unit& u, int wr, int wc, int fr, int fq) const {
        const int row0 = u.pm * 256 + wr * 64 + fr, col0 = u.pn * 256 + wc * 32 + 8 * fq;
#pragma unroll
        for (int ai = 0; ai < 2; ++ai)
#pragma unroll
            for (int m = 0; m < 4; ++m) {
                const int row = row0 + ai * 128 + m * 16;
#pragma unroll
                for (int bj = 0; bj < 2; ++bj) {
                    const f32x4 v0 = acc[ai][bj][m][0], v1 = acc[ai][bj][m][1];
                    u32x4 w; w.x = cvt_pk_bf16(v0[0], v0[1]); w.y = cvt_pk_bf16(v0[2], v0[3]); w.z = cvt_pk_bf16(v1[0], v1[1]); w.w = cvt_pk_bf16(v1[2], v1[3]);
                    *(u32x4*)(P + PADDR(row, QA + col0 + bj * 128)) = w;
                }
            }
    }
};

DI int srccol(int dr) {
    if (dr < 2048) return dr;
    if (dr < 5120) return dr - 2048 + 3088;
    if (dr < 6144) return dr - 5120 + 2048;
    if (dr < 7168) return dr - 6144 + 6160;
    if (dr < 8192) return dr - 7168 + 7200;
    return dr - 8192 + 8224;
}
DI void transpose_tile(const Params& p, LAS unsigned char* lds, int tile) {
    const int tid = laundered_tid();
    unsigned char* ws = p.ws;
    LAS float* tl = (LAS float*)lds;
    const float* src; bf16_t* dst; int ldsrc, kt, scol0;
    if (tile < 2304) { const int nt = tile >> 4; kt = tile & 15; src = p.in[10]; ldsrc = 9248; dst = (bf16_t*)(ws + WS_W1) + (size_t)nt * 64 * 1024; scol0 = srccol(nt * 64); }
    else { int t2 = tile - 2304; const int w = t2 >> 8; t2 &= 255; const int nt = t2 >> 4; kt = t2 & 15; src = p.in[18 + w]; ldsrc = 1024;
        dst = (bf16_t*)(ws + (w == 0 ? WS_WPA : (w == 1 ? WS_WPB : WS_WOUT))) + (size_t)nt * 64 * 1024; scol0 = nt * 64; }
    { const int c = tid & 63, kr = tid >> 6;
#pragma unroll
      for (int i = 0; i < 8; ++i) { const int k = kr + 8 * i; tl[k * 65 + c] = src[(size_t)(kt * 64 + k) * ldsrc + scol0 + c]; } }
    __syncthreads();
    { const int k2 = (tid & 31) * 2, nb = tid >> 5;
#pragma unroll
      for (int i = 0; i < 4; ++i) { const int n = nb + 16 * i; *(unsigned*)(dst + (size_t)n * 1024 + kt * 64 + k2) = cvt_pk_bf16(tl[k2 * 65 + n], tl[(k2 + 1) * 65 + n]); } }
    __syncthreads();
}
DI void phase_prep(const Params& p, LAS unsigned char* lds) {
    const int tid = laundered_tid();
    unsigned char* ws = p.ws;
    for (int ti = blockIdx.x; ti < 1792; ti += gridDim.x) transpose_tile(p, lds, ti < 1280 ? ti : ti + 1024);
    { bf16_t* wsm = (bf16_t*)(ws + WS_WSM); const float* win = p.in[10];
      for (int idx = blockIdx.x * NTHR + tid; idx < 32 * 1024; idx += gridDim.x * NTHR) { const int n = idx >> 10, k = idx & 1023;
          const int sc = n < 16 ? 3072 + n : (n < 24 ? 7184 + (n - 16) : 7192 + (n - 24)); wsm[idx] = (bf16_t)f2bf(win[(size_t)k * 9248 + sc]); } }
    if (blockIdx.x < 192) {
        LAS float* sc = (LAS float*)lds;
        LAS float* red = (LAS float*)(lds + 65536);
        const float* cp = p.in[2]; const float* cs = p.in[3]; const float* wada = p.in[7]; const float* bada = p.in[8];
        float* mod = (float*)(ws + WS_MOD);
        for (int i = tid; i < 16384; i += NTHR) { const int r = i >> 10, k = i & 1023; const float c = r < 8 ? cp[r * 1024 + k] : cs[(r - 8) * 1024 + k]; sc[i] = siluf_(c); }
        __syncthreads();
        for (int item = blockIdx.x; item < 192; item += gridDim.x) {
            const int j0 = item * 16, cl = tid & 15, kk = tid >> 4;
            float acc[16];
#pragma unroll
            for (int r = 0; r < 16; ++r) acc[r] = 0.f;
#pragma unroll 8
            for (int k = kk; k < 1024; k += 32) { const float w = wada[(size_t)k * 3072 + j0 + cl];
#pragma unroll
                for (int r = 0; r < 16; ++r) acc[r] += sc[r * 1024 + k] * w; }
#pragma unroll
            for (int r = 0; r < 16; ++r) red[kk * 256 + r * 16 + cl] = acc[r];
            __syncthreads();
            if (tid < 256) { float s = 0.f;
#pragma unroll
                for (int q = 0; q < 32; ++q) s += red[q * 256 + tid];
                const int r = tid >> 4, c = tid & 15; mod[r * 3072 + j0 + c] = s + bada[j0 + c]; }
            __syncthreads();
        }
    }
}

DI void phase_h(const Params& p) {
    const int tid = laundered_tid(), lane = tid & 63, w = tid >> 6;
    const float* g1 = p.in[9];
    const float* mod = (const float*)(p.ws + WS_MOD);
    bf16_t* H = (bf16_t*)p.out;
    const int nrow = MP + 128, stride = gridDim.x * 8;
    for (int vr0 = blockIdx.x * 8 + w; vr0 < nrow; vr0 += 2 * stride) {
        f32x4 v[2][4]; float ss[2]; bf16_t* hp[2]; const float* mp[2]; bool on[2];
#pragma unroll
        for (int q = 0; q < 2; ++q) {
            const int vr = vr0 + q * stride; on[q] = vr < nrow;
            const float* x; int row, b;
            if (!on[q]) { x = p.in[0]; row = 0; b = 0; }
            else if (vr < MP) { x = p.in[0] + (size_t)vr * 1024; row = vr; b = vr >> 12; }
            else { const int k = vr - MP; x = p.in[1] + (size_t)k * 1024; row = MP + (k >> 4) * 64 + (k & 15); b = 8 + (k >> 4); }
            hp[q] = H + (size_t)row * 128; mp[q] = mod + (size_t)b * 3072;
            float sacc = 0.f;
#pragma unroll
            for (int i = 0; i < 4; ++i) { v[q][i] = *(const f32x4*)(x + i * 256 + lane * 4); sacc += (v[q][i][0] * v[q][i][0] + v[q][i][1] * v[q][i][1]) + (v[q][i][2] * v[q][i][2] + v[q][i][3] * v[q][i][3]); }
            ss[q] = sacc;
        }
#pragma unroll
        for (int q = 0; q < 2; ++q) {
            float sacc = row16_sum(ss[q]); sacc += __shfl_xor(sacc, 16); sacc += __shfl_xor(sacc, 32);
            const float rstd = rsqrtf(sacc * (1.0f / 1024.0f) + EPS);
            if (on[q]) {
#pragma unroll
                for (int i = 0; i < 4; ++i) { const int c = i * 256 + lane * 4;
                    const f32x4 g = *(const f32x4*)(g1 + c), sc = *(const f32x4*)(mp[q] + 1024 + c), sh = *(const f32x4*)(mp[q] + c);
                    const f32x4 y = v[q][i] * rstd * g * (sc + 1.0f) + sh;
                    u32x2 o; o.x = cvt_pk_bf16(y[0], y[1]); o.y = cvt_pk_bf16(y[2], y[3]); *(u32x2*)(hp[q] + (size_t)(c >> 7) * MT * 128 + (c & 127)) = o; }
            }
        }
    }
}

DI void phase_small(const Params& p) {
    const int tid = laundered_tid(), lane = tid & 63, w = tid >> 6;
    const bf16_t* H = (const bf16_t*)p.out; const bf16_t* W = (const bf16_t*)(p.ws + WS_WSM);
    float* PS = (float*)(p.ws + WS_PS);
    for (int it = blockIdx.x * 8 + w; it < MP / 16 + 8; it += gridDim.x * 8) {
        const int row0 = it < MP / 16 ? it * 16 : MP + (it - MP / 16) * 64;
        const bf16_t* ap = H + (size_t)(row0 + (lane & 15)) * 128 + (lane >> 4) * 8;
        const bf16_t* bp = W + (size_t)(lane & 15) * 1024 + (lane >> 4) * 8;
        f32x4 a0 = {0.f, 0.f, 0.f, 0.f}, a1 = {0.f, 0.f, 0.f, 0.f};
#pragma unroll 8
        for (int k = 0; k < 1024; k += 32) { const bf16x8 a = *(const bf16x8*)(ap + (size_t)(k >> 7) * MT * 128 + (k & 127));
            a0 = MFMA16(a, *(const bf16x8*)(bp + k), a0); a1 = MFMA16(a, *(const bf16x8*)(bp + 16 * 1024 + k), a1); }
#pragma unroll
        for (int r = 0; r < 4; ++r) { float* o = PS + (size_t)(row0 + (lane >> 4) * 4 + r) * 32 + (lane & 15); o[0] = a0[r]; o[16] = a1[r]; }
    }
}


template <class F>
DI void gemm_small(const bf16_t* A, int lda, size_t wstep, const bf16_t* Bt, int N, const F& epi) {
    const int tid = laundered_tid(), lane = tid & 63, w = tid >> 6;
    const int ntask = 8 * (N / 32);
    for (int task = blockIdx.x * 8 + w; task < ntask; task += gridDim.x * 8) {
        const int s = task & 7, n0 = (task >> 3) * 32, rowbase = MP + s * 64;
        const bf16_t* ap = A + (size_t)(rowbase + (lane & 15)) * lda + (lane >> 4) * 8;
        const bf16_t* bp = Bt + (size_t)(n0 + (lane & 15)) * 1024 + (lane >> 4) * 8;
        f32x4 a0 = {0.f, 0.f, 0.f, 0.f}, a1 = {0.f, 0.f, 0.f, 0.f};
#pragma unroll 2
        for (int kw = 0; kw < 8; ++kw) {
#pragma unroll
            for (int kk = 0; kk < 4; ++kk) { const int k = kw * 128 + kk * 32; const bf16x8 a = *(const bf16x8*)(ap + kw * wstep + kk * 32);
                a0 = MFMA16(a, *(const bf16x8*)(bp + k), a0); a1 = MFMA16(a, *(const bf16x8*)(bp + 16 * 1024 + k), a1); } }
        epi(rowbase + (lane >> 4) * 4, n0 + (lane & 15), a0, a1, lane);
    }
}
struct SEpiG1 { bf16_t* P; float* convs;
    DI void operator()(int row, int col, const f32x4& a0, const f32x4& a1, int) const {
#pragma unroll
        for (int r = 0; r < 4; ++r) { const int rw = row + r, rl = rw & 63;
#pragma unroll
            for (int q = 0; q < 2; ++q) { const int cc = col + q * 16; const float v = q ? a1[r] : a0[r];
                P[PADDR(rw, cc)] = (bf16_t)f2bf(v);
                if (cc >= 2048 && rl >= 13) convs[((size_t)((rw - MP) >> 6) * 3 + (rl - 13)) * 3072 + (cc - 2048)] = v; } }
    } };
struct SEpiG1b { bf16_t* P; const float* ssa; const float* ssb; const float* gna; const float* gnb;
    DI void operator()(int row, int col, const f32x4& a0, const f32x4& a1, int) const {
        const int kind = col >> 10;
#pragma unroll
        for (int r = 0; r < 4; ++r) { const int rw = row + r;
#pragma unroll
            for (int q = 0; q < 2; ++q) { const int cc = (col & 1023) + q * 16; const float v = q ? a1[r] : a0[r];
                if (kind == 0) { const int head = cc >> 8; const float* sp = ssa + (size_t)rw * 32 + head * 8; float ss = 0.f;
#pragma unroll
                    for (int e = 0; e < 8; ++e) ss += sp[e];
                    bf16_t* d = P + PADDR(rw, VA + cc); *d = (bf16_t)f2bf(bf2f(*d) * rsqrtf(ss * (1.0f / 256.0f) + EPS) * gna[cc & 255] * fsilu(v)); }
                else if (kind == 1) { const int head = cc >> 7; const float* sp = ssb + (size_t)rw * 32 + head * 4; const float ss = (sp[0] + sp[1]) + (sp[2] + sp[3]);
                    bf16_t* d = P + PADDR(rw, GV + cc); *d = (bf16_t)f2bf(bf2f(*d) * rsqrtf(ss * (1.0f / 128.0f) + EPS) * gnb[cc & 127] * fsilu(v)); }
                else P[PADDR(rw, (kind == 2 ? QA : GQ) + cc)] = (bf16_t)f2bf(__builtin_amdgcn_rcpf(1.0f + __expf(-v))); } }
    } };
template <int SECOND>
struct SEpiMerge { bf16_t* P;
    DI void operator()(int row, int col, const f32x4& a0, const f32x4& a1, int) const {
#pragma unroll
        for (int r = 0; r < 4; ++r) { const int rw = row + r;
#pragma unroll
            for (int q = 0; q < 2; ++q) { const int cc = col + q * 16; const float v = q ? a1[r] : a0[r];
                const float sg = bf2f(P[PADDR(rw, (SECOND ? GQ : QA) + cc)]); bf16_t* d = P + PADDR(rw, GK + cc);
                *d = (bf16_t)f2bf(SECOND ? bf2f(*d) + sg * v : sg * v); } }
    } };
struct SEpiOut { bf16_t* P;
    DI void operator()(int row, int col, const f32x4& a0, const f32x4& a1, int) const {
#pragma unroll
        for (int r = 0; r < 4; ++r) { P[PADDR((row + r), QA + col)] = (bf16_t)f2bf(a0[r]); P[PADDR((row + r), QA + col + 16)] = (bf16_t)f2bf(a1[r]); }
    } };

template <bool DRY>
DI void gla1_item(const Params& p, LAS unsigned char* lds, int item, unsigned (&qn)[16], unsigned (&kn)[16], bool& have, int next) {
    const int tid = laundered_tid(), lane = tid & 63, w = tid >> 6;
    const int c = item >> 2, h = item & 3, r0 = c * 64, valid = c < 512 ? 64 : 16;
    LAS bf16_t* Qt = (LAS bf16_t*)lds;
    LAS bf16_t* Kt = Qt + 64 * 136;
    LAS float* gl = (LAS float*)(lds + 34816);
    LAS float* tot = (LAS float*)(lds + 34816 + 4096);
    bf16_t* P = (bf16_t*)(p.ws + WS_P); const float* PS = (const float*)(p.ws + WS_PS);
    bf16_t* ATT = (bf16_t*)(p.ws + WS_ATT); float* GDEC = (float*)(p.ws + WS_GDEC);
    const int dk = tid & 127, rg = tid >> 7;
    bf16_t* qp = P + PADDR((r0 + rg * 16), QA + h * 128 + dk); const bf16_t* kp = P + PADDR((r0 + rg * 16), KA + h * 128 + dk);
    unsigned qraw[16], kraw[16];
    if (have) {
#pragma unroll
        for (int i = 0; i < 16; ++i) { qraw[i] = qn[i]; kraw[i] = kn[i]; }
    } else {
#pragma unroll
        for (int i = 0; i < 16; ++i) { qraw[i] = qp[(size_t)i * PRS]; kraw[i] = kp[(size_t)i * PRS]; }
    }
    if (tid < 256) { const int row = tid >> 2, q4 = tid & 3; *(LAS f32x4*)(gl + row * 16 + q4 * 4) = *(const f32x4*)(PS + (size_t)(r0 + row) * 32 + q4 * 4); }
    float wv[16];
#pragma unroll
    for (int r = 0; r < 16; ++r) wv[r] = p.in[11][r * 512 + h * 128 + dk];
    const float bias = p.in[12][h * 128 + dk];
    __syncthreads();
    float bb[16]; float run = 0.f;
#pragma unroll
    for (int i = 0; i < 16; ++i) { const int row = rg * 16 + i; float z = bias;
#pragma unroll
        for (int r = 0; r < 16; ++r) z += gl[row * 16 + r] * wv[r];
        const float ls = fminf(z, 0.f) - __logf(1.0f + __expf(-fabsf(z)));
        const float g = row < valid ? ls * (1.0f / 16.0f) : 0.f; run += g; bb[i] = run; }
    tot[rg * 128 + dk] = run;
    asm volatile("s_waitcnt vmcnt(0)" ::: "memory");
    __syncthreads();
    const float t0 = tot[dk], t1 = tot[128 + dk], t2 = tot[256 + dk], t3 = tot[384 + dk];
    const float off = rg == 0 ? 0.f : (rg == 1 ? t0 : (rg == 2 ? t0 + t1 : t0 + t1 + t2));
    const float bref = t0 + t1, blast = (t0 + t1) + (t2 + t3);
    float kd[16];
#pragma unroll
    for (int i = 0; i < 16; ++i) { const int row = rg * 16 + i; const float b = bb[i] + off;
        const float qv = row < valid ? bf2f(qraw[i]) * 0.08838834764831845f : 0.f;
        const float kv = row < valid ? bf2f(kraw[i]) : 0.f;
        Qt[row * 136 + dk] = (bf16_t)f2bf(qv * __expf(b - bref)); Kt[row * 136 + dk] = (bf16_t)f2bf(kv * __expf(bref - b));
        if (!DRY) qp[(size_t)i * PRS] = (bf16_t)f2bf(qv * __expf(b));
        kd[i] = kv * __expf(blast - b); }
    if (rg == 0) GDEC[item * 128 + dk] = __expf(blast);
    have = next < NCH * 4;
    if (have) { const int cn = next >> 2, hn = next & 3;
        const bf16_t* qpn = P + PADDR((cn * 64 + rg * 16), QA + hn * 128 + dk); const bf16_t* kpn = P + PADDR((cn * 64 + rg * 16), KA + hn * 128 + dk);
#pragma unroll
        for (int i = 0; i < 16; ++i) { qn[i] = qpn[(size_t)i * PRS]; kn[i] = kpn[(size_t)i * PRS]; } }
    __syncthreads();
    { u32x4 w0, w1; w0.x = cvt_pk_bf16(kd[0], kd[1]); w0.y = cvt_pk_bf16(kd[2], kd[3]); w0.z = cvt_pk_bf16(kd[4], kd[5]); w0.w = cvt_pk_bf16(kd[6], kd[7]);
      w1.x = cvt_pk_bf16(kd[8], kd[9]); w1.y = cvt_pk_bf16(kd[10], kd[11]); w1.z = cvt_pk_bf16(kd[12], kd[13]); w1.w = cvt_pk_bf16(kd[14], kd[15]);
      bf16_t* d = P + PADDR((r0 + (dk >> 1)), KA + h * 128 + (dk & 1) * 64 + rg * 16); if (!DRY) { *(u32x4*)d = w0; *(u32x4*)(d + 8) = w1; } }
#pragma unroll
    for (int tt = 0; tt < 2; ++tt) { const int idx = w * 2 + tt, mt = idx >> 2, nt = idx & 3;
        f32x4 acc = {0.f, 0.f, 0.f, 0.f};
        if (mt <= nt) acc = mma16<128>(acc, Kt + mt * 16 * 136, 136, Qt + nt * 16 * 136, 136, lane);
        const int j0 = mt * 16 + (lane >> 4) * 4, i = nt * 16 + (lane & 15);
        u32x2 o; o.x = cvt_pk_bf16(j0 <= i ? acc[0] : 0.f, j0 + 1 <= i ? acc[1] : 0.f); o.y = cvt_pk_bf16(j0 + 2 <= i ? acc[2] : 0.f, j0 + 3 <= i ? acc[3] : 0.f);
        *(u32x2*)(ATT + (size_t)item * 4096 + i * 64 + j0) = o; }
    __syncthreads();
}

template <bool DRY>
DI void gdn1_item(const Params& p, LAS unsigned char* lds, int item, f32x2 (&wreg)[16], int& wh, u32x4 (&rawn)[11], bool& have, int next, float (&psn)[2], bool& havep) {
    const int tid = laundered_tid(), lane = tid & 63, w = __builtin_amdgcn_readfirstlane(tid >> 6);
    const int c = item >> 3, h = item & 7, r0 = c * 64, valid = c < 512 ? 64 : 16;
    LAS bf16_t* Kimg = (LAS bf16_t*)lds;
    LAS bf16_t* Qimg = Kimg + 64 * 136;
    LAS bf16_t* KD = Qimg + 64 * 136;
    LAS bf16_t* XT = (LAS bf16_t*)lds;
    LAS float* R = (LAS float*)(lds + 52224);
    LAS bf16_t* NA = (LAS bf16_t*)(lds + 118784);
    LAS float* AD = (LAS float*)(lds + 128000);
    LAS bf16_t* TI = (LAS bf16_t*)(lds + 132096);
    LAS float* gsh = (LAS float*)(lds + 133632);
    LAS float* besh = gsh + 64; LAS float* bsh = besh + 64;
    bf16_t* P = (bf16_t*)(p.ws + WS_P); const float* PS = (const float*)(p.ws + WS_PS);
    const bf16_t* halo = (const bf16_t*)(p.ws + WS_HALO);
    bf16_t* WK = (bf16_t*)(p.ws + WS_WK); bf16_t* QKb = (bf16_t*)(p.ws + WS_QK); float* BDEC = (float*)(p.ws + WS_BDEC);
    const float* wconv = p.in[13]; const float* cache = p.in[6];
    const int X = w >> 1;
    const int t7 = tid & 127, cg = t7 & 15, rseg = t7 >> 4;
    const int cb = X * 1024 + h * 128 + cg * 8;
    f32x2 f[11][4];
    if (w < 6) {
        if (wh != h) {
#pragma unroll
            for (int i = 0; i < 4; ++i) { const f32x4 a = *(const f32x4*)(wconv + (size_t)i * 3072 + cb), b = *(const f32x4*)(wconv + (size_t)i * 3072 + cb + 4);
                wreg[i * 4 + 0] = (f32x2){a[0], a[1]}; wreg[i * 4 + 1] = (f32x2){a[2], a[3]}; wreg[i * 4 + 2] = (f32x2){b[0], b[1]}; wreg[i * 4 + 3] = (f32x2){b[2], b[3]}; }
        }
        if (have) {
#pragma unroll
            for (int i = 0; i < 11; ++i) { const u32x4 a = rawn[i];
                f[i][0] = (f32x2){bflo(a.x), bfhi(a.x)}; f[i][1] = (f32x2){bflo(a.y), bfhi(a.y)}; f[i][2] = (f32x2){bflo(a.z), bfhi(a.z)}; f[i][3] = (f32x2){bflo(a.w), bfhi(a.w)}; }
        } else {
#pragma unroll
        for (int i = 0; i < 11; ++i) {
            const int rr = rseg * 8 - 3 + i;
            if (rr >= 0) { const u32x4 a = *(const u32x4*)(P + PADDR((r0 + rr), GQ + cb));
                f[i][0] = (f32x2){bflo(a.x), bfhi(a.x)}; f[i][1] = (f32x2){bflo(a.y), bfhi(a.y)}; f[i][2] = (f32x2){bflo(a.z), bfhi(a.z)}; f[i][3] = (f32x2){bflo(a.w), bfhi(a.w)}; }
            else if (c >= 512) { const float* sp = cache + ((size_t)(c - 512) * 3 + (3 + rr)) * 3072 + cb; const f32x4 a = *(const f32x4*)sp, b = *(const f32x4*)(sp + 4);
                f[i][0] = (f32x2){a[0], a[1]}; f[i][1] = (f32x2){a[2], a[3]}; f[i][2] = (f32x2){b[0], b[1]}; f[i][3] = (f32x2){b[2], b[3]}; }
            else if ((c & 63) == 0) {
#pragma unroll
                for (int e = 0; e < 4; ++e) f[i][e] = (f32x2){0.f, 0.f}; }
            else { const u32x4 a = *(const u32x4*)(halo + ((size_t)(c - 1) * 3 + (3 + rr)) * 3072 + cb);
                f[i][0] = (f32x2){bflo(a.x), bfhi(a.x)}; f[i][1] = (f32x2){bflo(a.y), bfhi(a.y)}; f[i][2] = (f32x2){bflo(a.z), bfhi(a.z)}; f[i][3] = (f32x2){bflo(a.w), bfhi(a.w)}; }
        }
        }
    } else if (w == 6) {
        const int row = lane; const bool rvalid = row < valid;
        const float bin = havep ? psn[0] : PS[(size_t)(r0 + row) * 32 + 16 + h], ain = havep ? psn[1] : PS[(size_t)(r0 + row) * 32 + 24 + h];
        const float be = rvalid ? __builtin_amdgcn_rcpf(1.0f + __expf(-bin)) : 0.f;
        float x = rvalid ? -__expf(p.in[14][h]) * softplusf_(ain + p.in[15][h]) : 0.f;
#pragma unroll
        for (int off = 1; off < 64; off <<= 1) { const float y = __shfl_up(x, off); if (lane >= off) x += y; }
        bsh[lane] = x; besh[lane] = be;
        if (lane == 63) BDEC[item] = __expf(x);
    }
    wh = h;
    asm volatile("s_waitcnt vmcnt(0)" ::: "memory");
    __syncthreads();
    if (w < 6) {
        const float bl = bsh[63];
#pragma unroll
        for (int o = 0; o < 8; ++o) {
            const int row = rseg * 8 + o; const bool rvalid = row < valid;
            float v[8];
#pragma unroll
            for (int e = 0; e < 4; ++e) { f32x2 a = f[o][e] * wreg[e];
                a = __builtin_elementwise_fma(f[o + 1][e], wreg[4 + e], a); a = __builtin_elementwise_fma(f[o + 2][e], wreg[8 + e], a); a = __builtin_elementwise_fma(f[o + 3][e], wreg[12 + e], a);
                v[2 * e] = rvalid ? fsilu(a.x) : 0.f; v[2 * e + 1] = rvalid ? fsilu(a.y) : 0.f; }
            const float bi = bsh[row], be = besh[row];
            if (X < 2) {
                float ss = 0.f;
#pragma unroll
                for (int e = 0; e < 8; ++e) ss += v[e] * v[e];
                ss = row16_sum(ss);
                const float rn = rsqrtf(ss + EPS) * (X == 0 ? 0.08838834764831845f : 1.0f);
#pragma unroll
                for (int e = 0; e < 8; ++e) v[e] *= rn;
                u32x4 o0; o0.x = cvt_pk_bf16(v[0], v[1]); o0.y = cvt_pk_bf16(v[2], v[3]); o0.z = cvt_pk_bf16(v[4], v[5]); o0.w = cvt_pk_bf16(v[6], v[7]);
                if (X == 0) {
                    *(LAS u32x4*)(Qimg + row * 136 + cg * 8) = o0;
                    const float eb = __expf(bi);
                    u32x4 o1; o1.x = cvt_pk_bf16(v[0] * eb, v[1] * eb); o1.y = cvt_pk_bf16(v[2] * eb, v[3] * eb); o1.z = cvt_pk_bf16(v[4] * eb, v[5] * eb); o1.w = cvt_pk_bf16(v[6] * eb, v[7] * eb);
                    if (!DRY) *(u32x4*)(P + PADDR((r0 + row), GQ + h * 128 + cg * 8)) = o1;
                } else {
                    *(LAS u32x4*)(Kimg + row * 136 + cg * 8) = o0;
                    const float ekd = __expf(bl - bi), bek = be * __expf(bi);
                    u32x4 o1; o1.x = cvt_pk_bf16(v[0] * ekd, v[1] * ekd); o1.y = cvt_pk_bf16(v[2] * ekd, v[3] * ekd); o1.z = cvt_pk_bf16(v[4] * ekd, v[5] * ekd); o1.w = cvt_pk_bf16(v[6] * ekd, v[7] * ekd);
                    *(LAS u32x4*)(KD + row * 136 + cg * 8) = o1;
                    f32x4 a, b;
#pragma unroll
                    for (int e = 0; e < 4; ++e) { a[e] = bek * v[e]; b[e] = bek * v[4 + e]; }
                    *(LAS f32x4*)(R + row * 260 + 128 + cg * 8) = a; *(LAS f32x4*)(R + row * 260 + 128 + cg * 8 + 4) = b;
                }
            } else {
                f32x4 a, b;
#pragma unroll
                for (int e = 0; e < 4; ++e) { a[e] = be * v[e]; b[e] = be * v[4 + e]; }
                *(LAS f32x4*)(R + row * 260 + cg * 8) = a; *(LAS f32x4*)(R + row * 260 + cg * 8 + 4) = b;
            }
        }
    }
    {
        const int cn = next >> 3, hn = next & 7;
        havep = next < NCH * 8;
        if (havep && w == 6) { psn[0] = PS[(size_t)(cn * 64 + lane) * 32 + 16 + hn]; psn[1] = PS[(size_t)(cn * 64 + lane) * 32 + 24 + hn]; }
        have = next < NCH * 8 && cn < 512;
        if (have && w < 6) {
            const int cbn = X * 1024 + hn * 128 + cg * 8; const u32x4 z = {0u, 0u, 0u, 0u};
#pragma unroll
            for (int i = 0; i < 11; ++i) { const int rr = rseg * 8 - 3 + i;
                if (rr >= 0) rawn[i] = *(const u32x4*)(P + PADDR((cn * 64 + rr), GQ + cbn));
                else if ((cn & 63) == 0) rawn[i] = z;
                else rawn[i] = *(const u32x4*)(halo + ((size_t)(cn - 1) * 3 + (3 + rr)) * 3072 + cbn); }
        }
    }
    __syncthreads();
#pragma unroll
    for (int tt = 0; tt < 2; ++tt) { const int idx = w * 2 + tt, mt = idx >> 2, nt = idx & 3;
        f32x4 acc = {0.f, 0.f, 0.f, 0.f};
        if (nt <= mt) acc = mma16<128>(acc, Kimg + mt * 16 * 136, 136, Kimg + nt * 16 * 136, 136, lane);
        const int i0 = mt * 16 + (lane >> 4) * 4, j = nt * 16 + (lane & 15); const float bj = bsh[j];
#pragma unroll
        for (int r = 0; r < 4; ++r) { const int i = i0 + r; const float a = j < i ? besh[i] * acc[r] * __expf(fminf(bsh[i] - bj, 0.f)) : 0.f;
            NA[i * 72 + j] = (bf16_t)f2bf(nt < mt ? -a : 0.f);
            if (nt == mt) AD[(mt * 16 + (i & 15)) * 16 + (j & 15)] = a; } }
#pragma unroll
    for (int tt = 0; tt < 2; ++tt) { const int idx = w * 2 + tt, mt = idx >> 2, nt = idx & 3;
        f32x4 acc = {0.f, 0.f, 0.f, 0.f};
        if (mt <= nt) acc = mma16<128>(acc, Kimg + mt * 16 * 136, 136, Qimg + nt * 16 * 136, 136, lane);
        const int j0 = mt * 16 + (lane >> 4) * 4, i = nt * 16 + (lane & 15); const float bi = bsh[i];
        float v[4];
#pragma unroll
        for (int r = 0; r < 4; ++r) v[r] = (j0 + r <= i) ? acc[r] * __expf(fminf(bi - bsh[j0 + r], 0.f)) : 0.f;
        u32x2 o; o.x = cvt_pk_bf16(v[0], v[1]); o.y = cvt_pk_bf16(v[2], v[3]);
        *(u32x2*)(QKb + (size_t)item * 4096 + i * 64 + j0) = o; }
    {
        const int dk = tid & 127, tq = tid >> 7;
        unsigned wv[8];
#pragma unroll
        for (int e = 0; e < 8; ++e) { const unsigned lo = KD[(tq * 16 + 2 * e) * 136 + dk], hi = KD[(tq * 16 + 2 * e + 1) * 136 + dk]; wv[e] = lo | (hi << 16); }
        bf16_t* d = P + PADDR((r0 + (dk >> 1)), GK + h * 128 + (dk & 1) * 64 + tq * 16);
        u32x4 o0, o1; o0.x = wv[0]; o0.y = wv[1]; o0.z = wv[2]; o0.w = wv[3]; o1.x = wv[4]; o1.y = wv[5]; o1.z = wv[6]; o1.w = wv[7];
        if (!DRY) { *(u32x4*)d = o0; *(u32x4*)(d + 8) = o1; }
    }
    __syncthreads();
    if (w == 0) {
        const int blk = lane >> 4, cc = lane & 15;
        const LAS float* A = AD + blk * 256;
        float t[16];
#pragma unroll
        for (int i = 0; i < 16; ++i) { float sacc = (i == cc) ? 1.0f : 0.0f;
#pragma unroll
            for (int j = 0; j < i; ++j) sacc -= A[i * 16 + j] * t[j];
            t[i] = sacc; TI[(blk * 16 + i) * 24 + cc] = (bf16_t)f2bf(sacc); }
    }
    __syncthreads();
    {
        const int g4 = (lane >> 4) * 4, m = lane & 15;
#pragma unroll
        for (int tt = 0; tt < 2; ++tt) {
            const int n0 = (w * 2 + tt) * 16;
            { const u32x4 z = {0u, 0u, 0u, 0u}; *(LAS u32x4*)(XT + (n0 + m) * 72 + g4 * 4) = z; *(LAS u32x4*)(XT + (n0 + m) * 72 + g4 * 4 + 8) = z; }
#pragma unroll
            for (int r = 0; r < 4; ++r) {
                f32x4 acc;
#pragma unroll
                for (int e = 0; e < 4; ++e) acc[e] = R[(r * 16 + g4 + e) * 260 + n0 + m];
                if (r > 0) acc = mma16<64>(acc, NA + r * 16 * 72, 72, XT + n0 * 72, 72, lane);
                u32x4 bw; bw.x = cvt_pk_bf16(acc[0], acc[1]); bw.y = cvt_pk_bf16(acc[2], acc[3]); bw.z = 0u; bw.w = 0u;
                const u32x2 tv = *(const LAS u32x2*)(TI + (r * 16 + m) * 24 + g4);
                u32x4 aw; aw.x = tv.x; aw.y = tv.y; aw.z = 0u; aw.w = 0u;
                f32x4 x = {0.f, 0.f, 0.f, 0.f};
                x = MFMA16(__builtin_bit_cast(bf16x8, aw), __builtin_bit_cast(bf16x8, bw), x);
                u32x2 o; o.x = cvt_pk_bf16(x[0], x[1]); o.y = cvt_pk_bf16(x[2], x[3]);
                *(LAS u32x2*)(XT + (n0 + m) * 72 + r * 16 + g4) = o;
            }
        }
    }
    __syncthreads();
#pragma unroll
    for (int l = 0; l < 2; ++l) { const int idx = tid + l * 512;
        {
            const int cc = idx >> 3, t8 = (idx & 7) * 8; const u32x4 v = *(const LAS u32x4*)(XT + cc * 72 + t8);
            if (!DRY) *(u32x4*)(P + PADDR((r0 + (cc & 63)), GV + h * 128 + (cc >> 6) * 64 + t8)) = v; }
        {
            const int tok = idx & 63, d8 = (idx >> 6) * 8; unsigned wv[4];
#pragma unroll
            for (int e = 0; e < 4; ++e) { const unsigned lo = XT[(128 + d8 + 2 * e) * 72 + tok], hi = XT[(128 + d8 + 2 * e + 1) * 72 + tok]; wv[e] = lo | (hi << 16); }
            u32x4 o; o.x = wv[0]; o.y = wv[1]; o.z = wv[2]; o.w = wv[3];
            *(u32x4*)(WK + (size_t)item * 8192 + tok * 128 + d8) = o; }
    }
    __syncthreads();
}

template <bool DRY>
DI void gla2_item(const Params& p, LAS unsigned char* lds, int item) {
    const int tid = laundered_tid(), lane = tid & 63, w = __builtin_amdgcn_readfirstlane(tid >> 6);
    const bool sample = item >= 128; const int it = item & 127;
    const int sq = it >> 4, h = (it >> 2) & 3, j4 = it & 3, dv0 = j4 * 64;
    const int c0 = sample ? 512 + sq : sq * 64, nch = sample ? 1 : 64, valid = sample ? 16 : 64;
    bf16_t* P = (bf16_t*)(p.ws + WS_P); const bf16_t* ATT = (const bf16_t*)(p.ws + WS_ATT); const float* GDEC = (const float*)(p.ws + WS_GDEC);
    float* SSA = (float*)(p.ws + WS_SSA);
    f32x4 Sacc[4];
    const int sdk = w * 16 + (lane >> 4) * 4;
#pragma unroll
    for (int nt = 0; nt < 4; ++nt) {
#pragma unroll
        for (int r = 0; r < 4; ++r) Sacc[nt][r] = sample ? p.in[4][((size_t)(sq * 4 + h) * 128 + sdk + r) * 256 + dv0 + nt * 16 + (lane & 15)] : 0.f;
    }
    struct RS { u32x4 ra, rq[2], rk[2], rv; float rd; };
    RS RA, RB; RA.rd = 0.f; RB.rd = 0.f;
    auto load = [&](int c, RS& R) {
        const int r0 = c * 64, ia = c * 4 + h;
        R.ra = *(const u32x4*)(ATT + (size_t)ia * 4096 + tid * 8);
#pragma unroll
        for (int l = 0; l < 2; ++l) { const int idx = tid + l * 512;
            { const int i = idx >> 4, d8 = (idx & 15) * 8; R.rq[l] = *(const u32x4*)(P + PADDR((r0 + i), QA + h * 128 + d8)); }
            { const int dk = idx >> 3, t8 = (idx & 7) * 8; R.rk[l] = *(const u32x4*)(P + PADDR((r0 + (dk >> 1)), KA + h * 128 + (dk & 1) * 64 + t8)); } }
        { const int tok = tid >> 3, e8 = (tid & 7) * 8; const u32x4 z = {0u, 0u, 0u, 0u};
          R.rv = tok < valid ? *(const u32x4*)(P + PADDR((r0 + tok), VA + h * 256 + dv0 + e8)) : z; }
        if (tid < 128) R.rd = GDEC[ia * 128 + tid];
    };
    auto store = [&](int b, const RS& R) {
        LAS unsigned char* base = lds + b * 54272;
        LAS bf16_t* att = (LAS bf16_t*)base; LAS bf16_t* qd = (LAS bf16_t*)(base + 9216); LAS bf16_t* kT = (LAS bf16_t*)(base + 26624); LAS bf16_t* vT = (LAS bf16_t*)(base + 45056);
        *(LAS u32x4*)(att + (tid >> 3) * 72 + (tid & 7) * 8) = R.ra;
#pragma unroll
        for (int l = 0; l < 2; ++l) { const int idx = tid + l * 512;
            *(LAS u32x4*)(qd + (idx >> 4) * 136 + (idx & 15) * 8) = R.rq[l];
            *(LAS u32x4*)(kT + (idx >> 3) * 72 + (idx & 7) * 8) = R.rk[l]; }
        { const int tok = tid >> 3, e8 = (tid & 7) * 8; const unsigned vv[4] = {R.rv.x, R.rv.y, R.rv.z, R.rv.w};
#pragma unroll
          for (int e = 0; e < 8; ++e) vT[(e8 + e) * 72 + tok] = (bf16_t)((vv[e >> 1] >> (16 * (e & 1))) & 0xffffu); }
        if (tid < 128) ((LAS float*)(lds + 143360 + b * 512))[tid] = R.rd;
    };
    auto writeST = [&](int b) {
        LAS bf16_t* ST = (LAS bf16_t*)(lds + 108544 + b * 17408);
#pragma unroll
        for (int nt = 0; nt < 4; ++nt) { u32x2 o; o.x = cvt_pk_bf16(Sacc[nt][0], Sacc[nt][1]); o.y = cvt_pk_bf16(Sacc[nt][2], Sacc[nt][3]);
            *(LAS u32x2*)(ST + (nt * 16 + (lane & 15)) * 136 + sdk) = o; }
    };
    load(c0, RA); store(0, RA); writeST(0);
    if (nch > 1) load(c0 + 1, RB);
    __syncthreads();
    auto step = [&](int n, RS& Rl, const RS& Rs) {
        const int cur = n & 1, r0 = (c0 + n) * 64;
        if (n + 2 < nch) load(c0 + n + 2, Rl);
        LAS unsigned char* base = lds + cur * 54272;
        const LAS bf16_t* att = (const LAS bf16_t*)base; const LAS bf16_t* qd = (const LAS bf16_t*)(base + 9216);
        const LAS bf16_t* kT = (const LAS bf16_t*)(base + 26624); const LAS bf16_t* vT = (const LAS bf16_t*)(base + 45056);
        const LAS bf16_t* ST = (const LAS bf16_t*)(lds + 108544 + cur * 17408);
        const LAS float* dec = (const LAS float*)(lds + 143360 + cur * 512);
        bf16x8 bvall[4][2];
        {
            const int mt = w >> 1, nt0 = (w & 1) * 2; float ssq[4] = {0.f, 0.f, 0.f, 0.f};
            const int tok0 = mt * 16 + (lane >> 4) * 4;
            bf16x8 aa[2], aqd[4], bs[2][4];
#pragma unroll
            for (int k2 = 0; k2 < 2; ++k2) { aa[k2] = ldfrag(att + mt * 16 * 72, 72, lane, k2 * 32);
#pragma unroll
                for (int nt = 0; nt < 4; ++nt) bvall[nt][k2] = ldfrag(vT + nt * 16 * 72, 72, lane, k2 * 32); }
#pragma unroll
            for (int k4 = 0; k4 < 4; ++k4) { aqd[k4] = ldfrag(qd + mt * 16 * 136, 136, lane, k4 * 32); bs[0][k4] = ldfrag(ST + nt0 * 16 * 136, 136, lane, k4 * 32); bs[1][k4] = ldfrag(ST + (nt0 + 1) * 16 * 136, 136, lane, k4 * 32); }
            __builtin_amdgcn_sched_barrier(0);
            f32x4 acc[2] = {{0.f, 0.f, 0.f, 0.f}, {0.f, 0.f, 0.f, 0.f}};
#pragma unroll
            for (int k2 = 0; k2 < 2; ++k2) {
                if (w & 1) { acc[0] = MFMA16(aa[k2], bvall[2][k2], acc[0]); acc[1] = MFMA16(aa[k2], bvall[3][k2], acc[1]); }
                else { acc[0] = MFMA16(aa[k2], bvall[0][k2], acc[0]); acc[1] = MFMA16(aa[k2], bvall[1][k2], acc[1]); } }
#pragma unroll
            for (int k4 = 0; k4 < 4; ++k4) { acc[0] = MFMA16(aqd[k4], bs[0][k4], acc[0]); acc[1] = MFMA16(aqd[k4], bs[1][k4], acc[1]); }
#pragma unroll
            for (int tt = 0; tt < 2; ++tt) {
                bf16_t* d = P + PADDR((r0 + tok0), VA + h * 256 + dv0 + (nt0 + tt) * 16 + (lane & 15));
#pragma unroll
                for (int r = 0; r < 4; ++r) { if (!DRY) d[(size_t)r * PRS] = (bf16_t)f2bf(acc[tt][r]); ssq[r] += acc[tt][r] * acc[tt][r]; } }
#pragma unroll
            for (int r = 0; r < 4; ++r) { const float s = row16_sum(ssq[r]);
                if ((lane & 15) == 0) SSA[(size_t)(r0 + tok0 + r) * 32 + h * 8 + j4 * 2 + (w & 1)] = s; }
        }
        {
            const f32x4 dv = *(const LAS f32x4*)(dec + sdk);
            bf16x8 ak[2];
#pragma unroll
            for (int k2 = 0; k2 < 2; ++k2) ak[k2] = ldfrag(kT + w * 16 * 72, 72, lane, k2 * 32);
            __builtin_amdgcn_sched_barrier(0);
#pragma unroll
            for (int nt = 0; nt < 4; ++nt) Sacc[nt] = Sacc[nt] * dv;
#pragma unroll
            for (int k2 = 0; k2 < 2; ++k2)
#pragma unroll
                for (int nt = 0; nt < 4; ++nt) Sacc[nt] = MFMA16(ak[k2], bvall[nt][k2], Sacc[nt]);
            writeST(cur ^ 1);
        }
        if (n + 1 < nch) store(cur ^ 1, Rs);
        __syncthreads();
    };
    for (int n = 0; n < nch; n += 2) { step(n, RA, RB); if (n + 1 < nch) step(n + 1, RB, RA); }
    float* so = p.out + (sample ? O_SGLAS : O_SGLAP);
#pragma unroll
    for (int nt = 0; nt < 4; ++nt)
#pragma unroll
        for (int r = 0; r < 4; ++r) so[((size_t)(sq * 4 + h) * 128 + sdk + r) * 256 + dv0 + nt * 16 + (lane & 15)] = Sacc[nt][r];
    __syncthreads();
}

template <bool DRY>
DI void gdn2_item(const Params& p, LAS unsigned char* lds, int item) {
    const int tid = laundered_tid(), lane = tid & 63, w = __builtin_amdgcn_readfirstlane(tid >> 6);
    const bool sample = item >= 128; const int it = item & 127;
    const int sq = it >> 4, h = (it >> 1) & 7, j2 = it & 1, dv0 = j2 * 64;
    const int c0 = sample ? 512 + sq : sq * 64, nch = sample ? 1 : 64;
    bf16_t* P = (bf16_t*)(p.ws + WS_P); const bf16_t* WK = (const bf16_t*)(p.ws + WS_WK); const bf16_t* QKb = (const bf16_t*)(p.ws + WS_QK);
    const float* BDEC = (const float*)(p.ws + WS_BDEC); float* SSB = (float*)(p.ws + WS_SSB);
    LAS bf16_t* wk = (LAS bf16_t*)lds;
    LAS bf16_t* qd = (LAS bf16_t*)(lds + 17408);
    LAS bf16_t* kT = (LAS bf16_t*)(lds + 34816);
    LAS bf16_t* qk = (LAS bf16_t*)(lds + 53248);
    LAS bf16_t* uv = (LAS bf16_t*)(lds + 62464);
    LAS bf16_t* ST = (LAS bf16_t*)(lds + 71680);
    LAS bf16_t* uT = (LAS bf16_t*)(lds + 89088);
    f32x4 Sacc[4];
    const int sdk = w * 16 + (lane >> 4) * 4;
#pragma unroll
    for (int nt = 0; nt < 4; ++nt) {
#pragma unroll
        for (int r = 0; r < 4; ++r) Sacc[nt][r] = sample ? p.in[5][((size_t)(sq * 8 + h) * 128 + sdk + r) * 128 + dv0 + nt * 16 + (lane & 15)] : 0.f;
    }
    struct RS { u32x4 rw[2], rq[2], rk[2], rqk, ruv; float bdn; };
    RS RA, RB; RA.bdn = 1.f; RB.bdn = 1.f; float bd = 1.f;
    auto load = [&](int c, RS& R) {
        const int r0 = c * 64, ib = c * 8 + h;
#pragma unroll
        for (int l = 0; l < 2; ++l) { const int idx = tid + l * 512;
            R.rw[l] = *(const u32x4*)(WK + (size_t)ib * 8192 + idx * 8);
            { const int i = idx >> 4, d8 = (idx & 15) * 8; R.rq[l] = *(const u32x4*)(P + PADDR((r0 + i), GQ + h * 128 + d8)); }
            { const int dk = idx >> 3, t8 = (idx & 7) * 8; R.rk[l] = *(const u32x4*)(P + PADDR((r0 + (dk >> 1)), GK + h * 128 + (dk & 1) * 64 + t8)); } }
        R.rqk = *(const u32x4*)(QKb + (size_t)ib * 4096 + tid * 8);
        { const int dvl = tid >> 3, t8 = (tid & 7) * 8; R.ruv = *(const u32x4*)(P + PADDR((r0 + dvl), GV + h * 128 + dv0 + t8)); }
        R.bdn = BDEC[ib];
    };
    auto store = [&](const RS& R) {
#pragma unroll
        for (int l = 0; l < 2; ++l) { const int idx = tid + l * 512;
            *(LAS u32x4*)(wk + (idx >> 4) * 136 + (idx & 15) * 8) = R.rw[l];
            *(LAS u32x4*)(qd + (idx >> 4) * 136 + (idx & 15) * 8) = R.rq[l];
            *(LAS u32x4*)(kT + (idx >> 3) * 72 + (idx & 7) * 8) = R.rk[l]; }
        *(LAS u32x4*)(qk + (tid >> 3) * 72 + (tid & 7) * 8) = R.rqk;
        *(LAS u32x4*)(uv + (tid >> 3) * 72 + (tid & 7) * 8) = R.ruv;
    };
    auto writeST = [&]() {
#pragma unroll
        for (int nt = 0; nt < 4; ++nt) { u32x2 o; o.x = cvt_pk_bf16(Sacc[nt][0], Sacc[nt][1]); o.y = cvt_pk_bf16(Sacc[nt][2], Sacc[nt][3]);
            *(LAS u32x2*)(ST + (nt * 16 + (lane & 15)) * 136 + sdk) = o; }
    };
    load(c0, RA); store(RA); writeST(); bd = RA.bdn;
    if (nch > 1) load(c0 + 1, RB);
    __syncthreads();
    auto step = [&](int n, RS& Rl, const RS& Rs) {
        const int r0 = (c0 + n) * 64;
        if (n + 2 < nch) load(c0 + n + 2, Rl);
        const int mt = w >> 1, tok0 = mt * 16 + (lane >> 4) * 4;
        f32x4 O1[2];
        {
            const int nt0 = (w & 1) * 2;
            bf16x8 aw[4], aq[4], b0[4], b1[4];
#pragma unroll
            for (int k4 = 0; k4 < 4; ++k4) { aw[k4] = ldfrag(wk + mt * 16 * 136, 136, lane, k4 * 32); aq[k4] = ldfrag(qd + mt * 16 * 136, 136, lane, k4 * 32);
                b0[k4] = ldfrag(ST + nt0 * 16 * 136, 136, lane, k4 * 32); b1[k4] = ldfrag(ST + (nt0 + 1) * 16 * 136, 136, lane, k4 * 32); }
            __builtin_amdgcn_sched_barrier(0);
            f32x4 pa0 = {0.f, 0.f, 0.f, 0.f}, pa1 = {0.f, 0.f, 0.f, 0.f}; O1[0] = (f32x4){0.f, 0.f, 0.f, 0.f}; O1[1] = (f32x4){0.f, 0.f, 0.f, 0.f};
#pragma unroll
            for (int k4 = 0; k4 < 4; ++k4) { pa0 = MFMA16(aw[k4], b0[k4], pa0); pa1 = MFMA16(aw[k4], b1[k4], pa1); O1[0] = MFMA16(aq[k4], b0[k4], O1[0]); O1[1] = MFMA16(aq[k4], b1[k4], O1[1]); }
#pragma unroll
            for (int tt = 0; tt < 2; ++tt) { const int dv = (nt0 + tt) * 16 + (lane & 15); const f32x4 pa = tt ? pa1 : pa0;
                const u32x2 uvv = *(const LAS u32x2*)(uv + dv * 72 + tok0);
                float u[4];
                u[0] = bflo(uvv.x) - pa[0]; u[1] = bfhi(uvv.x) - pa[1]; u[2] = bflo(uvv.y) - pa[2]; u[3] = bfhi(uvv.y) - pa[3];
                u32x2 o; o.x = cvt_pk_bf16(u[0], u[1]); o.y = cvt_pk_bf16(u[2], u[3]);
                *(LAS u32x2*)(uT + dv * 72 + tok0) = o; }
        }
        __syncthreads();
        {
            float ssq[4] = {0.f, 0.f, 0.f, 0.f};
            const int nt0 = (w & 1) * 2;
            bf16x8 aqk[2], ak[2], bu[4][2];
#pragma unroll
            for (int k2 = 0; k2 < 2; ++k2) { aqk[k2] = ldfrag(qk + mt * 16 * 72, 72, lane, k2 * 32); ak[k2] = ldfrag(kT + w * 16 * 72, 72, lane, k2 * 32);
#pragma unroll
                for (int nt = 0; nt < 4; ++nt) bu[nt][k2] = ldfrag(uT + nt * 16 * 72, 72, lane, k2 * 32); }
            __builtin_amdgcn_sched_barrier(0);
#pragma unroll
            for (int nt = 0; nt < 4; ++nt) Sacc[nt] = Sacc[nt] * bd;
#pragma unroll
            for (int k2 = 0; k2 < 2; ++k2) {
                if (w & 1) { O1[0] = MFMA16(aqk[k2], bu[2][k2], O1[0]); O1[1] = MFMA16(aqk[k2], bu[3][k2], O1[1]); }
                else { O1[0] = MFMA16(aqk[k2], bu[0][k2], O1[0]); O1[1] = MFMA16(aqk[k2], bu[1][k2], O1[1]); }
#pragma unroll
                for (int nt = 0; nt < 4; ++nt) Sacc[nt] = MFMA16(ak[k2], bu[nt][k2], Sacc[nt]); }
#pragma unroll
            for (int tt = 0; tt < 2; ++tt) { const int nt = nt0 + tt;
                bf16_t* d = P + PADDR((r0 + tok0), GV + h * 128 + dv0 + nt * 16 + (lane & 15));
#pragma unroll
                for (int r = 0; r < 4; ++r) { if (!DRY) d[(size_t)r * PRS] = (bf16_t)f2bf(O1[tt][r]); ssq[r] += O1[tt][r] * O1[tt][r]; } }
#pragma unroll
            for (int r = 0; r < 4; ++r) { const float sacc = row16_sum(ssq[r]);
                if ((lane & 15) == 0) SSB[(size_t)(r0 + tok0 + r) * 32 + h * 4 + j2 * 2 + (w & 1)] = sacc; }
        }
        __syncthreads();
        writeST();
        if (n + 1 < nch) { store(Rs); bd = Rs.bdn; }
        __syncthreads();
    };
    for (int n = 0; n < nch; n += 2) { step(n, RA, RB); if (n + 1 < nch) step(n + 1, RB, RA); }
    float* so = p.out + (sample ? O_SGDNS : O_SGDNP);
#pragma unroll
    for (int nt = 0; nt < 4; ++nt)
#pragma unroll
        for (int r = 0; r < 4; ++r) so[((size_t)(sq * 8 + h) * 128 + sdk + r) * 128 + dv0 + nt * 16 + (lane & 15)] = Sacc[nt][r];
    __syncthreads();
}

DI void phase_final(const Params& p, bool dry) {
    const int tid = laundered_tid(), lane = tid & 63, w = tid >> 6;
    const bf16_t* P = (const bf16_t*)(p.ws + WS_P); const float* mod = (const float*)(p.ws + WS_MOD); const float* gf = p.in[21];
    const int nrow = MP + 128, stride = gridDim.x * 8;
    for (int vr0 = blockIdx.x * 8 + w; vr0 < nrow; vr0 += 2 * stride) {
        f32x4 xv[2][4]; float ss[2]; float* yp[2]; bool on[2];
#pragma unroll
        for (int q = 0; q < 2; ++q) {
            const int vr = vr0 + q * stride; on[q] = vr < nrow;
            int row, b; const float* x;
            if (!on[q]) { row = 0; b = 0; x = p.in[0]; yp[q] = p.out; }
            else if (vr < MP) { row = vr; b = vr >> 12; x = p.in[0] + (size_t)vr * 1024; yp[q] = p.out + O_YP + (size_t)vr * 1024; }
            else { const int k = vr - MP; row = MP + (k >> 4) * 64 + (k & 15); b = 8 + (k >> 4); x = p.in[1] + (size_t)k * 1024; yp[q] = p.out + O_YS + (size_t)k * 1024; }
            const float* gt = mod + (size_t)b * 3072 + 2048;
            float s = 0.f;
#pragma unroll
            for (int i = 0; i < 4; ++i) { const int c = i * 256 + lane * 4;
                const f32x4 xx = *(const f32x4*)(x + c), gg = *(const f32x4*)(gt + c); const u32x2 ov = *(const u32x2*)(P + PADDR(row, QA + c));
                f32x4 r; r[0] = xx[0] + gg[0] * bflo(ov.x); r[1] = xx[1] + gg[1] * bfhi(ov.x); r[2] = xx[2] + gg[2] * bflo(ov.y); r[3] = xx[3] + gg[3] * bfhi(ov.y);
                xv[q][i] = r; s += (r[0] * r[0] + r[1] * r[1]) + (r[2] * r[2] + r[3] * r[3]); }
            ss[q] = s;
        }
#pragma unroll
        for (int q = 0; q < 2; ++q) {
            float s = row16_sum(ss[q]); s += __shfl_xor(s, 16); s += __shfl_xor(s, 32);
            const float rstd = rsqrtf(s * (1.0f / 1024.0f) + EPS);
            if (on[q] && !dry) {
#pragma unroll
                for (int i = 0; i < 4; ++i) { const int c = i * 256 + lane * 4; const f32x4 g = *(const f32x4*)(gf + c); *(f32x4*)(yp[q] + c) = xv[q][i] * rstd * g; }
            }
        }
    }
}

__global__ void __launch_bounds__(NTHR) fwd_megakernel(Params p) {
    extern __shared__ __attribute__((aligned(16))) unsigned char lds_raw[];
    LAS unsigned char* lds = (LAS unsigned char*)lds_raw;
    cg::grid_group grid = cg::this_grid();
    unsigned char* ws = p.ws;
    bf16_t* P = (bf16_t*)(ws + WS_P);
    volatile LAS unsigned* xb_st = (volatile LAS unsigned*)(lds + (LDS_BYTES - 16));
    if (threadIdx.x < 4) xb_st[threadIdx.x] = 0u;
    __syncthreads();
    const XcdBarrier xbar = xcd_barrier_post((unsigned*)(ws + WS_BAR), xb_st);
    {
#if PROBE_DUP == 1
        phase_prep(p, lds);
        xcd_barrier(xbar);
        phase_h(p);
        xcd_barrier(xbar);
        phase_small(p);
        xcd_barrier(xbar);
#endif
        phase_prep(p, lds);
        xcd_barrier(xbar);
        if (p.ph_hi == 777) grid.sync();
        phase_h(p);
        xcd_barrier(xbar);
        {
            phase_small(p);
            gemm_small((const bf16_t*)p.out, 128, (size_t)MT * 128, (const bf16_t*)(ws + WS_W1), 5120, SEpiG1{P, p.out + O_CONVS});
            pg8::Gemm g{(const bf16_t*)p.out, (const bf16_t*)(ws + WS_W1), MP, 5120, 1024, 128, (size_t)MT * 256};
            pg8::StaticOrder S; S.init(MP, 5120, gridDim.x, blockIdx.x);
            EpiG1 E{P, (bf16_t*)(ws + WS_HALO), p.out + O_CONVP, p.out + O_CONVS};
            pg8::gemm_phase(lds, g, S, E);
        }
        xcd_barrier(xbar);
#if PROBE_DUP == 2
        {
            pg8::Gemm g{(const bf16_t*)p.out, (const bf16_t*)(ws + WS_W1), MP, 5120, 1024, 128, (size_t)MT * 256};
            pg8::StaticOrder S; S.init(MP, 5120, gridDim.x, blockIdx.x);
            EpiG1 E{P, (bf16_t*)(ws + WS_HALO), p.out + O_CONVP, p.out + O_CONVS};
            pg8::gemm_phase(lds, g, S, E);
        }
        xcd_barrier(xbar);
#endif


        {
            f32x2 wreg[16]; int wh = -1;
#pragma unroll
            for (int i = 0; i < 16; ++i) wreg[i] = (f32x2){0.f, 0.f};
            {
                u32x4 rawn[11]; bool have = false; float psn[2] = {0.f, 0.f}; bool havep = false;
#pragma unroll
                for (int i = 0; i < 11; ++i) rawn[i] = (u32x4){0u, 0u, 0u, 0u};
                for (int item = blockIdx.x; item < NCH * 8; item += gridDim.x) gdn1_item<false>(p, lds, item, wreg, wh, rawn, have, item + (int)gridDim.x, psn, havep);
            }
            {
                unsigned qn[16], kn[16]; bool have = false;
#pragma unroll
                for (int i = 0; i < 16; ++i) { qn[i] = 0u; kn[i] = 0u; }
                const int first = (int)(((NCH * 8 - (int)blockIdx.x + (int)gridDim.x - 1) / (int)gridDim.x) * (int)gridDim.x + (int)blockIdx.x) - NCH * 8;
                for (int item = first; item < NCH * 4; item += gridDim.x) gla1_item<false>(p, lds, item, qn, kn, have, item + (int)gridDim.x);
            }
        }
        xcd_barrier(xbar);
#if PROBE_DUP == 4
        for (int item = blockIdx.x; item < 512; item += gridDim.x) {
            const int grp = item >> 7, it = item & 127;
            if ((grp & 1) == 0) gdn2_item<true>(p, lds, it + (grp >> 1) * 128); else gla2_item<true>(p, lds, it + (grp >> 1) * 128);
        }
        xcd_barrier(xbar);
#endif
#if PROBE_DUP == 41
        for (int item = blockIdx.x; item < 512; item += gridDim.x) {
            const int grp = item >> 7, it = item & 127;
            if ((grp & 1) == 0) gdn2_item<true>(p, lds, it + (grp >> 1) * 128);
        }
        xcd_barrier(xbar);
#endif
#if PROBE_DUP == 42
        for (int item = blockIdx.x; item < 512; item += gridDim.x) {
            const int grp = item >> 7, it = item & 127;
            if ((grp & 1) == 1) gla2_item<true>(p, lds, it + (grp >> 1) * 128);
        }
        xcd_barrier(xbar);
#endif
        {
            for (int b = blockIdx.x; b < 512; b += gridDim.x) {
                const int rnd = b >> 8, bb = b & 255;
                if (bb < 128) { const int pair = (bb & 7) + 8 * (bb >> 4), j2 = (bb >> 3) & 1; if (rnd == 0) gdn2_item<false>(p, lds, pair * 2 + j2); }
                else { const int b2 = bb - 128, quad = (b2 & 7) + 8 * (b2 >> 5), j4 = (b2 >> 3) & 3; gla2_item<false>(p, lds, quad * 4 + j4 + rnd * 128);
                    if (rnd == 1) { const int pair = (b2 & 7) + 8 * (b2 >> 4), j2 = (b2 >> 3) & 1; gdn2_item<false>(p, lds, pair * 2 + j2 + 128);
                        for (int tj = b2; tj < 1280; tj += 128) transpose_tile(p, lds, tj < 1024 ? 1280 + tj : 2816 + (tj - 1024)); } }
            }
        }
        xcd_barrier(xbar);
#if PROBE_DUP == 5
        {
            pg8::Gemm g{(const bf16_t*)p.out, (const bf16_t*)(ws + WS_W1) + (size_t)5120 * 1024, MP, 4096, 1024, 128, (size_t)MT * 256};
            pg8::StaticOrder S; S.init(MP, 4096, gridDim.x, blockIdx.x);
            EpiG1b E{P, (const float*)(ws + WS_SSA), (const float*)(ws + WS_SSB), p.in[16], p.in[17], p.ph_hi != 777};
            pg8::gemm_phase(lds, g, S, E);
        }
        xcd_barrier(xbar);
#endif
        {
            gemm_small((const bf16_t*)p.out, 128, (size_t)MT * 128, (const bf16_t*)(ws + WS_W1) + (size_t)5120 * 1024, 4096, SEpiG1b{P, (const float*)(ws + WS_SSA), (const float*)(ws + WS_SSB), p.in[16], p.in[17]});
            pg8::Gemm g{(const bf16_t*)p.out, (const bf16_t*)(ws + WS_W1) + (size_t)5120 * 1024, MP, 4096, 1024, 128, (size_t)MT * 256};
            pg8::StaticOrder S; S.init(MP, 4096, gridDim.x, blockIdx.x);
            EpiG1b E{P, (const float*)(ws + WS_SSA), (const float*)(ws + WS_SSB), p.in[16], p.in[17], false};
            pg8::gemm_phase(lds, g, S, E);
        }
        xcd_barrier(xbar);
#if PROBE_DUP == 6
        {
            pg8::Gemm g{P + PADDR(0, VA), (const bf16_t*)(ws + WS_WPA), MP, 1024, 1024, 128, (size_t)MT * 256};
            pg8::StaticOrder S; S.init(MP, 1024, gridDim.x, blockIdx.x);
            EpiMerge<0> E{P, p.ph_hi != 777};
            pg8::gemm_phase(lds, g, S, E);
        }
        {
            pg8::Gemm g{P + PADDR(0, GV), (const bf16_t*)(ws + WS_WPB), MP, 1024, 1024, 128, (size_t)MT * 256};
            pg8::StaticOrder S; S.init(MP, 1024, gridDim.x, blockIdx.x);
            EpiMerge<1> E{P, p.ph_hi != 777};
            pg8::gemm_phase(lds, g, S, E);
        }
        xcd_barrier(xbar);
#endif
        {
            gemm_small(P + PADDR(0, VA), 128, (size_t)MT * 128, (const bf16_t*)(ws + WS_WPA), 1024, SEpiMerge<0>{P});
            pg8::Gemm g{P + PADDR(0, VA), (const bf16_t*)(ws + WS_WPA), MP, 1024, 1024, 128, (size_t)MT * 256};
            pg8::StaticOrder S; S.init(MP, 1024, gridDim.x, blockIdx.x);
            EpiMerge<0> E{P, false};
            pg8::gemm_phase(lds, g, S, E);
        }
        {
            gemm_small(P + PADDR(0, GV), 128, (size_t)MT * 128, (const bf16_t*)(ws + WS_WPB), 1024, SEpiMerge<1>{P});
            pg8::Gemm g{P + PADDR(0, GV), (const bf16_t*)(ws + WS_WPB), MP, 1024, 1024, 128, (size_t)MT * 256};
            pg8::StaticOrder S; S.init(MP, 1024, gridDim.x, blockIdx.x);
            EpiMerge<1> E{P, false};
            pg8::gemm_phase(lds, g, S, E);
        }
        xcd_barrier(xbar);
        {
            gemm_small(P + PADDR(0, GK), 128, (size_t)MT * 128, (const bf16_t*)(ws + WS_WOUT), 1024, SEpiOut{P});
            pg8::Gemm g{P + PADDR(0, GK), (const bf16_t*)(ws + WS_WOUT), MP, 1024, 1024, 128, (size_t)MT * 256};
            pg8::StaticOrder S; S.init(MP, 1024, gridDim.x, blockIdx.x);
            EpiOut E{P};
            pg8::gemm_phase(lds, g, S, E);
        }
        xcd_barrier(xbar);
#if PROBE_DUP == 9
        phase_final(p, p.ph_hi != 777);
        xcd_barrier(xbar);
#endif
#if PROBE_DUP == 8
        {
            pg8::Gemm g{P + PADDR(0, GK), (const bf16_t*)(ws + WS_WOUT), MP, 1024, 1024, 128, (size_t)MT * 256};
            pg8::StaticOrder S; S.init(MP, 1024, gridDim.x, blockIdx.x);
            EpiOut E{P};
            pg8::gemm_phase(lds, g, S, E);
        }
        xcd_barrier(xbar);
#endif
#if PROBE_DUP == 20
        for (int q = 0; q < 10; ++q) xcd_barrier(xbar);
#endif
        phase_final(p, false);
    }
}

extern "C" void kernel_launch(void* const* d_in, const int* in_sizes, int n_in, void* d_out, int out_size, void* d_ws, size_t ws_size, hipStream_t stream) {
    static int grid_blocks = 0;
    if (!grid_blocks) {
        if (ws_size < WS_END || n_in != 22) { fprintf(stderr, "kernel_launch: ws %zu < %zu or n_in %d\n", ws_size, (size_t)WS_END, n_in); grid_blocks = -1; return; }
        int dev = 0, cus = 0, per_cu = 0;
        (void)hipGetDevice(&dev);
        (void)hipDeviceGetAttribute(&cus, hipDeviceAttributeMultiprocessorCount, dev);
        (void)hipFuncSetAttribute((const void*)fwd_megakernel, hipFuncAttributeMaxDynamicSharedMemorySize, LDS_BYTES);
        (void)hipOccupancyMaxActiveBlocksPerMultiprocessor(&per_cu, (const void*)fwd_megakernel, NTHR, LDS_BYTES);
        if (per_cu < 1) per_cu = 1;
        grid_blocks = cus * per_cu;
        (void)hipGetLastError();
    }
    if (grid_blocks < 0) return;
    Params p{};
    for (int i = 0; i < 22; ++i) p.in[i] = (const float*)d_in[i];
    p.out = (float*)d_out; p.ws = (unsigned char*)d_ws;
    p.ph_lo = 0; p.ph_hi = 10;
    (void)hipMemsetAsync((unsigned char*)d_ws + WS_BAR, 0, (size_t)XCD_BAR_WORDS * 4, stream);
    void* args[] = {&p};
    hipError_t e = hipLaunchCooperativeKernel((const void*)fwd_megakernel, dim3(grid_blocks), dim3(NTHR), args, LDS_BYTES, stream);
    if (e != hipSuccess) fprintf(stderr, "cooperative launch failed: %s (grid %d)\n", hipGetErrorString(e), grid_blocks);
}
```

```cpp
#define PROBE_DUP 0
#include <hip/hip_runtime.h>
#include <hip/hip_cooperative_groups.h>
#include <cstdio>
namespace cg = cooperative_groups;

#define LAS __attribute__((address_space(3)))
#define DI __device__ __forceinline__
typedef unsigned short bf16_t;
typedef short bf16x8 __attribute__((ext_vector_type(8)));
typedef float f32x4 __attribute__((ext_vector_type(4)));
typedef unsigned u32x4 __attribute__((ext_vector_type(4)));
typedef unsigned u32x2 __attribute__((ext_vector_type(2)));
typedef float f32x2 __attribute__((ext_vector_type(2)));

#ifndef N_LAUNCH_PER_PHASE
#define N_LAUNCH_PER_PHASE 0
#endif

constexpr int MP = 32768;
constexpr int MT = 33280;
constexpr int NCH = 520;
constexpr int PLD = 5120;
constexpr int QA = 0, KA = 512, VA = 1024, GQ = 2048, GK = 3072, GV = 4096;
constexpr float EPS = 1e-6f;
#define PADDR(row, col) (((size_t)((col) >> 7) * MT + (size_t)(row)) * 128 + ((col) & 127))
constexpr int PRS = 128;
constexpr int NTHR = 512;
constexpr int LDS_BYTES = 147456;

constexpr size_t al256(size_t x) { return (x + 255) & ~(size_t)255; }
constexpr size_t WS_P    = 0;
constexpr size_t WS_W1   = al256(WS_P + (size_t)MT * PLD * 2);
constexpr size_t WS_WSM  = al256(WS_W1 + (size_t)9216 * 1024 * 2);
constexpr size_t WS_WPA  = al256(WS_WSM + (size_t)32 * 1024 * 2);
constexpr size_t WS_WPB  = WS_WPA + 2097152;
constexpr size_t WS_WOUT = WS_WPB + 2097152;
constexpr size_t WS_MOD  = WS_WOUT + 2097152;
constexpr size_t WS_PS   = al256(WS_MOD + (size_t)16 * 3072 * 4);
constexpr size_t WS_HALO = al256(WS_PS + (size_t)MT * 32 * 4);
constexpr size_t WS_ATT  = al256(WS_HALO + (size_t)NCH * 3 * 3072 * 2);
constexpr size_t WS_GDEC = al256(WS_ATT + (size_t)NCH * 4 * 4096 * 2);
constexpr size_t WS_WK   = al256(WS_GDEC + (size_t)NCH * 4 * 128 * 4);
constexpr size_t WS_QK   = al256(WS_WK + (size_t)NCH * 8 * 8192 * 2);
constexpr size_t WS_BDEC = al256(WS_QK + (size_t)NCH * 8 * 4096 * 2);
constexpr size_t WS_SSA  = al256(WS_BDEC + (size_t)NCH * 8 * 4);
constexpr size_t WS_SSB  = al256(WS_SSA + (size_t)MT * 32 * 4);
constexpr size_t WS_SSY  = al256(WS_SSB + (size_t)MT * 32 * 4);
constexpr size_t WS_SSYS = al256(WS_SSY + (size_t)MT * 16 * 4);
constexpr size_t WS_BAR  = al256(WS_SSYS + (size_t)512 * 32 * 4);
constexpr size_t WS_END  = al256(WS_BAR + (size_t)4096 * 4);

constexpr size_t O_YP = 0, O_YS = 33554432, O_SGLAP = 33685504, O_SGDNP = 34734080, O_CONVP = 35782656,
                 O_SGLAS = 35856384, O_SGDNS = 36904960, O_CONVS = 37953536;

struct Params { const float* in[22]; float* out; unsigned char* ws; int ph_lo, ph_hi; };

typedef __bf16 bf16v2_t __attribute__((ext_vector_type(2)));
DI unsigned cvt_pk_bf16(float lo, float hi) { bf16v2_t v = {(__bf16)lo, (__bf16)hi}; return __builtin_bit_cast(unsigned, v); }
DI unsigned f2bf(float x) { return (unsigned)__builtin_bit_cast(unsigned short, (__bf16)x); }
DI float bf2f(unsigned b) { return __uint_as_float(b << 16); }
DI float bflo(unsigned w) { return __uint_as_float(w << 16); }
DI float bfhi(unsigned w) { return __uint_as_float(w & 0xffff0000u); }
DI float sigmoidf_(float x) { return 1.0f / (1.0f + __expf(-x)); }
DI float siluf_(float x) { return x / (1.0f + __expf(-x)); }
DI float fsilu(float x) { return x * __builtin_amdgcn_rcpf(1.0f + __expf(-x)); }
DI float softplusf_(float x) { const float e = __expf(-fabsf(x)); return fmaxf(x, 0.f) + (e < 1e-4f ? e - 0.5f * e * e : 0.6931471805599453f * __builtin_amdgcn_logf(1.0f + e)); }
DI float logsigmoidf_(float x) { return -softplusf_(-x); }
DI int laundered_tid() { int t = threadIdx.x; asm volatile("" : "+v"(t)); return t; }
DI float row16_sum(float x) {
    x += __builtin_bit_cast(float, __builtin_amdgcn_update_dpp(0, __builtin_bit_cast(int, x), 0xB1, 0xF, 0xF, true));
    x += __builtin_bit_cast(float, __builtin_amdgcn_update_dpp(0, __builtin_bit_cast(int, x), 0x4E, 0xF, 0xF, true));
    x += __builtin_bit_cast(float, __builtin_amdgcn_update_dpp(0, __builtin_bit_cast(int, x), 0x141, 0xF, 0xF, true));
    x += __builtin_bit_cast(float, __builtin_amdgcn_update_dpp(0, __builtin_bit_cast(int, x), 0x140, 0xF, 0xF, true));
    return x;
}
#define MFMA16(a, b, c) __builtin_amdgcn_mfma_f32_16x16x32_bf16((a), (b), (c), 0, 0, 0)

DI bf16x8 ldfrag(const LAS bf16_t* base, int ld, int lane, int k) { return *(const LAS bf16x8*)(base + (lane & 15) * ld + (lane >> 4) * 8 + k); }
template <int K>
DI f32x4 mma16(f32x4 acc, const LAS bf16_t* A, int lda, const LAS bf16_t* Bt, int ldb, int lane) {
    const LAS bf16_t* ap = A + (lane & 15) * lda + (lane >> 4) * 8;
    const LAS bf16_t* bp = Bt + (lane & 15) * ldb + (lane >> 4) * 8;
#pragma unroll
    for (int k = 0; k < K; k += 32) acc = MFMA16(*(const LAS bf16x8*)(ap + k), *(const LAS bf16x8*)(bp + k), acc);
    return acc;
}

#define XB_TMO      128
#define XB_XCNT(j)  (256  + 64 * (j))
#define XB_XSUB(j)  (1280 + 64 * (j))
#define XB_XGEN(j)  (2304 + 64 * (j))
#define XB_TOP      3328
#define XB_TOPGEN   3392
#define XCD_BAR_WORDS 3456
#define XB_SPIN_CAP (1u << 18)

__device__ __forceinline__ unsigned xb_ld(unsigned* p)              { return __hip_atomic_load(p, __ATOMIC_RELAXED, __HIP_MEMORY_SCOPE_AGENT); }
__device__ __forceinline__ unsigned xb_add(unsigned* p, unsigned v) { return __hip_atomic_fetch_add(p, v, __ATOMIC_RELAXED, __HIP_MEMORY_SCOPE_AGENT); }
__device__ __forceinline__ unsigned xb_xcc_id() { return (unsigned)__builtin_amdgcn_s_getreg((3 << 11) | 20) & 0xFu; }
#define XB_SPIN(cond, bar) do { unsigned _sp = 0; while (cond) { __builtin_amdgcn_s_sleep(1); \
    if ((++_sp & 255u) == 0u) { if (xb_ld(&(bar)[XB_TMO])) break; if (_sp > XB_SPIN_CAP) { atomicAdd(&(bar)[XB_TMO], 1u); break; } } } } while (0)

struct XcdBarrier {
    unsigned* bar; unsigned x;
    volatile LAS unsigned* st;
};

__device__ __forceinline__ XcdBarrier xcd_barrier_post(unsigned* bar, volatile LAS unsigned* st) {
    XcdBarrier b; b.bar = bar; b.x = xb_xcc_id(); b.st = st;
    if (threadIdx.x == 0) (void)xb_add(&bar[XB_XCNT(b.x)], 1u);
    return b;
}
__device__ __forceinline__ void xcd_barrier_complete(unsigned* bar, unsigned x, unsigned& nloc, unsigned& nx) {
    const unsigned G = gridDim.x * gridDim.y * gridDim.z;
    unsigned sum, cnt, mine, sp = 0u;
    for (;;) {
        sum = 0u; cnt = 0u; mine = 0u;
#pragma unroll
        for (unsigned j = 0; j < 16; ++j) { const unsigned c = xb_ld(&bar[XB_XCNT(j)]); sum += c; cnt += (c > 0u) ? 1u : 0u; mine = (j == x) ? c : mine; }
        if (sum == G) break;
        __builtin_amdgcn_s_sleep(1);
        if ((++sp & 255u) == 0u) { if (xb_ld(&bar[XB_TMO])) break; if (sp > XB_SPIN_CAP) { atomicAdd(&bar[XB_TMO], 1u); break; } }
    }
    nloc = mine > 0u ? mine : 1u; nx = cnt > 0u ? cnt : 1u;
}

__device__ __forceinline__ void xcd_barrier(const XcdBarrier& b) {
    asm volatile("s_waitcnt vmcnt(0)" ::: "memory");
    __syncthreads();
    if (threadIdx.x == 0) {
        unsigned* bar = b.bar;
        __builtin_amdgcn_s_waitcnt(0);
        unsigned nloc = b.st[0], nx = b.st[1];
        if (nloc == 0u) { xcd_barrier_complete(bar, b.x, nloc, nx); b.st[0] = nloc; b.st[1] = nx; }
        const unsigned old = xb_add(&bar[XB_XSUB(b.x)], 1u);
        const unsigned gen = old / nloc;
        if (old + 1u == (gen + 1u) * nloc) {
            __builtin_amdgcn_fence(__ATOMIC_RELEASE, "agent");
            asm volatile("s_waitcnt vmcnt(0)" ::: "memory");
            const unsigned og = xb_add(&bar[XB_TOP], 1u);
            const unsigned tg = og / nx;
            if (og + 1u == (tg + 1u) * nx) xb_add(&bar[XB_TOPGEN], 1u);
            else XB_SPIN(xb_ld(&bar[XB_TOPGEN]) == tg, bar);
            __builtin_amdgcn_fence(__ATOMIC_ACQUIRE, "agent");
            xb_add(&bar[XB_XGEN(b.x)], 1u);
            asm volatile("s_waitcnt vmcnt(0)" ::: "memory");
        } else {
            XB_SPIN(xb_ld(&bar[XB_XGEN(b.x)]) == gen, bar);
            __builtin_amdgcn_fence(__ATOMIC_ACQUIRE, "agent");
            asm volatile("s_waitcnt vmcnt(0)" ::: "memory");
        }
    }
    __syncthreads();
}


namespace pg8 {
constexpr int BM = 256, BK = 64, HALF = 128, HTB = HALF * BK * 2, STAGE_BYTES = 8 * HTB, NXCD = 8, WGM = 8;
DI int lds_byte(int r, int c) { const int st = (r >> 4) * 2 + (c >> 5), rr = r & 15, cc = c & 31, ob = rr * 64 + cc * 2; return st * 1024 + (ob ^ (((ob >> 9) & 1) << 5)); }
DI void stage_rc(int b, int& R, int& C) { const int st = b / 1024, sb = b % 1024, swz = sb ^ (((sb >> 9) & 1) << 5); R = (st >> 1) * 16 + swz / 64; C = (st & 1) * 32 + (swz % 64) / 2; }
DI int perm32(int rho) { const int n = rho >> 4, i = rho & 15; return 8 * (i >> 2) + 4 * n + (i & 3); }
struct Unit { int pm, pn; };
struct Gemm { const bf16_t* A; const bf16_t* Bt; int M, N, K, lda; size_t wstepA; };
struct StaticOrder {
    int nM, nN, nwg, G, c;
    DI void init(int M, int N, int G_, int c_) { nM = M / BM; nN = N / BM; nwg = nM * nN; G = G_; c = c_; }
    DI bool next(int i, Unit& u) const {
        const long L = (long)i * G + c; if (L >= nwg) return false;
        int wgid = (int)L; { const int q = nwg / NXCD, r = nwg % NXCD, xcd = wgid % NXCD, off = wgid / NXCD; wgid = (xcd < r ? xcd * (q + 1) : r * (q + 1) + (xcd - r) * q) + off; }
        const int nig = WGM * nN, gid = wgid / nig, fm = gid * WGM, gsz = (nM - fm) < WGM ? (nM - fm) : WGM;
        u.pm = fm + ((wgid % nig) % gsz); u.pn = (wgid % nig) / gsz; return true;
    }
};

template <class Epi>
DI void gemm_phase(LAS unsigned char* lds, const Gemm g, const StaticOrder& S, const Epi& E) {
    const int tid = laundered_tid(), wid = __builtin_amdgcn_readfirstlane(tid >> 6), lane = tid & 63, wr = wid >> 2, wc = wid & 3, fr = lane & 15, fq = lane >> 4;
    const int K = g.K, nt = K / BK, lda = g.lda;
    unsigned voffA[2], voffB[2];
#pragma unroll
    for (int i = 0; i < 2; ++i) { int R, C; stage_rc(tid * 16 + i * 8192, R, C); const int Rb = Epi::PERM ? ((R & ~31) + perm32(R & 31)) : R;
        voffA[i] = (unsigned)(R * lda + C) * 2u; voffB[i] = (unsigned)(Rb * K + C) * 2u; }
    const size_t kstep = (size_t)(BK * 2);
    const size_t hstepA = (size_t)HALF * lda * 2, hstepB = (size_t)HALF * K * 2;
    const size_t tstepA = 2 * hstepA, tstepB = 2 * hstepB;
    const unsigned ldsw = (unsigned)wid * 1024u;
    const int aoff = lds_byte(wr * 64 + fr, fq * 8), boff = lds_byte(wc * 32 + fr, fq * 8);
#define PG8_SA(b, h) (((b) * 2 + (h)) * HTB)
#define PG8_SB(b, h) ((4 + (b) * 2 + (h)) * HTB)
#define PG8_STAGE(bufoff, gbase, voff) do { _Pragma("unroll") for (int _i = 0; _i < 2; ++_i) \
        __builtin_amdgcn_global_load_lds((const unsigned*)((const char*)(gbase) + (voff)[_i]), (LAS unsigned*)(lds + (bufoff) + ldsw + _i * 8192), 16, 0, 0); } while (0)
#define PG8_LDA(dst, b, h) do { _Pragma("unroll") for (int m = 0; m < 4; ++m) _Pragma("unroll") for (int k = 0; k < 2; ++k) dst[m][k] = *(const LAS bf16x8*)(lds + PG8_SA(b, h) + aoff + m * 2048 + k * 1024); } while (0)
#define PG8_LDB(dst, b, h) do { _Pragma("unroll") for (int n = 0; n < 2; ++n) _Pragma("unroll") for (int k = 0; k < 2; ++k) dst[n][k] = *(const LAS bf16x8*)(lds + PG8_SB(b, h) + boff + n * 2048 + k * 1024); } while (0)
#define PG8_MMA(ai, bj, At, Bt) do { __builtin_amdgcn_s_setprio(1); _Pragma("unroll") for (int m = 0; m < 4; ++m) _Pragma("unroll") for (int n = 0; n < 2; ++n) _Pragma("unroll") for (int k = 0; k < 2; ++k) \
        acc[ai][bj][m][n] = __builtin_amdgcn_mfma_f32_16x16x32_bf16(Bt[n][k], At[m][k], acc[ai][bj][m][n], 0, 0, 0); __builtin_amdgcn_s_setprio(0); } while (0)
#define PG8_WAIT_V(n) asm volatile("s_waitcnt vmcnt(" #n ")" ::: "memory")
#define PG8_WAIT_L(n) asm volatile("s_waitcnt lgkmcnt(" #n ")" ::: "memory")
#define PG8_BAR __builtin_amdgcn_s_barrier()
#define PG8_SCHED __builtin_amdgcn_sched_barrier(0)
    Unit cur, nxt; int ui = 0;
    if (!S.next(0, cur)) return;
    f32x4 acc[2][2][4][2];
#pragma unroll
    for (int a = 0; a < 2; ++a)
#pragma unroll
        for (int b = 0; b < 2; ++b)
#pragma unroll
            for (int m = 0; m < 4; ++m)
#pragma unroll
                for (int n = 0; n < 2; ++n) acc[a][b][m][n] = (f32x4){0.f, 0.f, 0.f, 0.f};
    bf16x8 At[4][2], B0[2][2], B1[2][2];
    const char* cA = (const char*)g.A + (size_t)cur.pm * tstepA; const char* cB = (const char*)g.Bt + (size_t)cur.pn * tstepB;
    PG8_STAGE(PG8_SB(0, 0), cB, voffB); PG8_STAGE(PG8_SA(0, 0), cA, voffA); PG8_STAGE(PG8_SB(0, 1), cB + hstepB, voffB); PG8_STAGE(PG8_SA(0, 1), cA + hstepA, voffA);
    if (wr == 1) PG8_BAR;
    PG8_WAIT_V(4); PG8_BAR;
    PG8_STAGE(PG8_SB(1, 0), cB + kstep, voffB); PG8_STAGE(PG8_SA(1, 0), cA + kstep, voffA); PG8_STAGE(PG8_SB(1, 1), cB + hstepB + kstep, voffB);
    PG8_WAIT_V(6); PG8_BAR;
    for (;;) {
        const bool has_next = S.next(ui + 1, nxt);
        const char* nA = has_next ? (const char*)g.A + (size_t)nxt.pm * tstepA : cA; const char* nB = has_next ? (const char*)g.Bt + (size_t)nxt.pn * tstepB : cB;
        for (int t = 0; t < nt; t += 2) {
            const bool last = (t == nt - 2);
            const char* aT = cA + (size_t)(t >> 1) * g.wstepA;
            const char* a1 = aT + kstep;
            const char* a2 = last ? nA : aT + g.wstepA; const char* b2 = last ? nB : cB + (size_t)(t + 2) * kstep;
            const char* a3 = a2 + kstep; const char* b3 = b2 + kstep;
            PG8_LDB(B0, 0, 0); PG8_SCHED; PG8_LDA(At, 0, 0); PG8_STAGE(PG8_SA(1, 1), a1 + hstepA, voffA);
            PG8_WAIT_L(8); PG8_BAR; PG8_WAIT_L(0); PG8_MMA(0, 0, At, B0); PG8_BAR; PG8_SCHED;
            PG8_LDB(B1, 0, 1); PG8_STAGE(PG8_SB(0, 0), b2, voffB);
            PG8_BAR; PG8_WAIT_L(0); PG8_MMA(0, 1, At, B1); PG8_BAR;
            PG8_LDA(At, 0, 1); PG8_STAGE(PG8_SA(0, 0), a2, voffA);
            PG8_BAR; PG8_WAIT_L(0); PG8_MMA(1, 0, At, B0); PG8_BAR; PG8_SCHED;
            PG8_STAGE(PG8_SB(0, 1), b2 + hstepB, voffB);
            PG8_WAIT_V(6); PG8_BAR; PG8_MMA(1, 1, At, B1); PG8_BAR;
            PG8_LDB(B0, 1, 0); PG8_SCHED; PG8_LDA(At, 1, 0); PG8_STAGE(PG8_SA(0, 1), a2 + hstepA, voffA);
            PG8_WAIT_L(8); PG8_BAR; PG8_WAIT_L(0); PG8_MMA(0, 0, At, B0); PG8_BAR; PG8_SCHED;
            PG8_LDB(B1, 1, 1); PG8_STAGE(PG8_SB(1, 0), b3, voffB);
            PG8_BAR; PG8_WAIT_L(0); PG8_MMA(0, 1, At, B1); PG8_BAR;
            PG8_LDA(At, 1, 1); PG8_STAGE(PG8_SA(1, 0), a3, voffA);
            PG8_BAR; PG8_WAIT_L(0); PG8_MMA(1, 0, At, B0); PG8_BAR; PG8_SCHED;
            PG8_STAGE(PG8_SB(1, 1), b3 + hstepB, voffB);
            PG8_WAIT_V(6); PG8_BAR; PG8_MMA(1, 1, At, B1); PG8_BAR;
        }
        E(acc, cur, wr, wc, fr, fq);
        if (!has_next) break;
#pragma unroll
        for (int a = 0; a < 2; ++a)
#pragma unroll
            for (int b = 0; b < 2; ++b)
#pragma unroll
                for (int m = 0; m < 4; ++m)
#pragma unroll
                    for (int n = 0; n < 2; ++n) acc[a][b][m][n] = (f32x4){0.f, 0.f, 0.f, 0.f};
        cur = nxt; cA = nA; cB = nB; ++ui;
    }
    PG8_WAIT_V(0);
    if (wr == 0) PG8_BAR;
    PG8_BAR;
#undef PG8_SA
#undef PG8_SB
#undef PG8_STAGE
#undef PG8_LDA
#undef PG8_LDB
#undef PG8_MMA
#undef PG8_WAIT_V
#undef PG8_WAIT_L
#undef PG8_BAR
#undef PG8_SCHED
}
}
using pg8::Unit;
typedef f32x4 AccT[2][2][4][2];

struct EpiG1 {
    static constexpr bool PERM = true;
    bf16_t* P; bf16_t* halo; float* convp; float* convs;
    DI void operator()(const AccT& acc, const Unit& u, int wr, int wc, int fr, int fq) const {
        const int row0 = u.pm * 256 + wr * 64 + fr, col0 = u.pn * 256 + wc * 32 + 8 * fq;
#pragma unroll
        for (int ai = 0; ai < 2; ++ai)
#pragma unroll
            for (int m = 0; m < 4; ++m) {
                const int row = row0 + ai * 128 + m * 16;
#pragma unroll
                for (int bj = 0; bj < 2; ++bj) {
                    const int col = col0 + bj * 128;
                    const f32x4 v0 = acc[ai][bj][m][0], v1 = acc[ai][bj][m][1];
                    u32x4 w; w.x = cvt_pk_bf16(v0[0], v0[1]); w.y = cvt_pk_bf16(v0[2], v0[3]); w.z = cvt_pk_bf16(v1[0], v1[1]); w.w = cvt_pk_bf16(v1[2], v1[3]);
                    __builtin_nontemporal_store(w, (u32x4*)(P + PADDR(row, col)));
                    if (u.pn >= 8) {
                        const int gcol = col - 2048, rl = row & 63;
                        if (rl >= 61) *(u32x4*)(halo + ((size_t)(row >> 6) * 3 + (rl - 61)) * 3072 + gcol) = w;
                        float* dst = nullptr;
                        if (row < MP) { if ((row & 4095) >= 4093) dst = convp + ((size_t)(row >> 12) * 3 + ((row & 4095) - 4093)) * 3072 + gcol; }
                        else if (rl >= 13 && rl < 16) dst = convs + ((size_t)((row - MP) >> 6) * 3 + (rl - 13)) * 3072 + gcol;
                        if (dst) { *(f32x4*)dst = v0; *(f32x4*)(dst + 4) = v1; }
                    }
                }
            }
    }
};
struct EpiG1b {
    static constexpr bool PERM = true;
    bf16_t* P; const float* ssa; const float* ssb; const float* gna; const float* gnb; bool dry;
    DI void operator()(const AccT& acc, const Unit& u, int wr, int wc, int fr, int fq) const {
        const int row0 = u.pm * 256 + wr * 64 + fr, ct0 = wc * 32 + 8 * fq;
        const int kind = u.pn >> 2, sub = u.pn & 3;
        float gg[2][8];
#pragma unroll
        for (int bj = 0; bj < 2; ++bj) { const int ct = ct0 + bj * 128; const float* gn = kind == 0 ? gna + ct : gnb + (ct & 127);
            const f32x4 g0 = kind <= 1 ? *(const f32x4*)gn : (f32x4){0.f, 0.f, 0.f, 0.f}, g1 = kind <= 1 ? *(const f32x4*)(gn + 4) : (f32x4){0.f, 0.f, 0.f, 0.f};
            gg[bj][0] = g0[0]; gg[bj][1] = g0[1]; gg[bj][2] = g0[2]; gg[bj][3] = g0[3]; gg[bj][4] = g1[0]; gg[bj][5] = g1[1]; gg[bj][6] = g1[2]; gg[bj][7] = g1[3]; }
#pragma unroll
        for (int ai = 0; ai < 2; ++ai)
#pragma unroll
            for (int m = 0; m < 4; ++m) {
                const int row = row0 + ai * 128 + m * 16;
                float rstdA = 0.f;
                if (kind == 0) { const f32x4 s0 = *(const f32x4*)(ssa + (size_t)row * 32 + sub * 8), s1 = *(const f32x4*)(ssa + (size_t)row * 32 + sub * 8 + 4);
                    rstdA = rsqrtf(((s0[0] + s0[1]) + (s0[2] + s0[3]) + (s1[0] + s1[1]) + (s1[2] + s1[3])) * (1.0f / 256.0f) + EPS); }
#pragma unroll
                for (int bj = 0; bj < 2; ++bj) {
                    const int ct = ct0 + bj * 128;
                    const f32x4 v0 = acc[ai][bj][m][0], v1 = acc[ai][bj][m][1];
                    float z[8] = {v0[0], v0[1], v0[2], v0[3], v1[0], v1[1], v1[2], v1[3]};
                    float o[8];
                    bf16_t* dst;
                    if (kind <= 1) {
                        float rstd;
                        if (kind == 0) { dst = P + PADDR(row, VA + sub * 256 + ct); rstd = rstdA; }
                        else { dst = P + PADDR(row, GV + sub * 256 + ct); const int head = sub * 2 + bj;
                            const f32x4 s0 = *(const f32x4*)(ssb + (size_t)row * 32 + head * 4);
                            rstd = rsqrtf(((s0[0] + s0[1]) + (s0[2] + s0[3])) * (1.0f / 128.0f) + EPS); }
                        const u32x4 ov = *(const u32x4*)dst;
                        const float of[8] = {bflo(ov.x), bfhi(ov.x), bflo(ov.y), bfhi(ov.y), bflo(ov.z), bfhi(ov.z), bflo(ov.w), bfhi(ov.w)};
#pragma unroll
                        for (int e = 0; e < 8; ++e) o[e] = of[e] * rstd * gg[bj][e] * fsilu(z[e]);
                    } else {
                        dst = P + PADDR(row, (kind == 2 ? QA : GQ) + sub * 256 + ct);
#pragma unroll
                        for (int e = 0; e < 8; ++e) o[e] = __builtin_amdgcn_rcpf(1.0f + __expf(-z[e]));
                    }
                    u32x4 w; w.x = cvt_pk_bf16(o[0], o[1]); w.y = cvt_pk_bf16(o[2], o[3]); w.z = cvt_pk_bf16(o[4], o[5]); w.w = cvt_pk_bf16(o[6], o[7]);
                    if (!dry) *(u32x4*)dst = w;
                }
            }
    }
};
template <int SECOND>
struct EpiMerge {
    static constexpr bool PERM = true;
    bf16_t* P; bool dry;
    DI void operator()(const AccT& acc, const Unit& u, int wr, int wc, int fr, int fq) const {
        const int row0 = u.pm * 256 + wr * 64 + fr, col0 = u.pn * 256 + wc * 32 + 8 * fq;
#pragma unroll
        for (int ai = 0; ai < 2; ++ai)
#pragma unroll
            for (int m = 0; m < 4; ++m) {
                const int row = row0 + ai * 128 + m * 16;
#pragma unroll
                for (int bj = 0; bj < 2; ++bj) {
                    const int col = col0 + bj * 128;
                    const f32x4 v0 = acc[ai][bj][m][0], v1 = acc[ai][bj][m][1];
                    const float z[8] = {v0[0], v0[1], v0[2], v0[3], v1[0], v1[1], v1[2], v1[3]};
                    const u32x4 sg = *(const u32x4*)(P + PADDR(row, (SECOND ? GQ : QA) + col));
                    const float sf[8] = {bflo(sg.x), bfhi(sg.x), bflo(sg.y), bfhi(sg.y), bflo(sg.z), bfhi(sg.z), bflo(sg.w), bfhi(sg.w)};
                    bf16_t* dst = P + PADDR(row, GK + col);
                    float o[8];
                    if (SECOND) { const u32x4 tv = *(const u32x4*)dst;
                        const float tf[8] = {bflo(tv.x), bfhi(tv.x), bflo(tv.y), bfhi(tv.y), bflo(tv.z), bfhi(tv.z), bflo(tv.w), bfhi(tv.w)};
#pragma unroll
                        for (int e = 0; e < 8; ++e) o[e] = tf[e] + sf[e] * z[e];
                    } else {
#pragma unroll
                        for (int e = 0; e < 8; ++e) o[e] = sf[e] * z[e];
                    }
                    u32x4 w; w.x = cvt_pk_bf16(o[0], o[1]); w.y = cvt_pk_bf16(o[2], o[3]); w.z = cvt_pk_bf16(o[4], o[5]); w.w = cvt_pk_bf16(o[6], o[7]);
                    if (!dry) *(u32x4*)dst = w;
                }
            }
    }
};
struct EpiOut {
    static constexpr bool PERM = true;
    bf16_t* P;
    DI void operator()(const AccT& acc, const Unit& u, int wr, int wc, int fr, int fq) const {
        const int row0 = u.pm * 256 + wr * 64 + fr, col0 = u.pn * 256 + wc * 32 + 8 * fq;
#pragma unroll
        for (int ai = 0; ai < 2; ++ai)
#pragma unroll
            for (int m = 0; m < 4; ++m) {
                const int row = row0 + ai * 128 + m * 16;
#pragma unroll
                for (int bj = 0; bj < 2; ++bj) {
                    const f32x4 v0 = acc[ai][bj][m][0], v1 = acc[ai][bj][m][1];
                    u32x4 w; w.x = cvt_pk_bf16(v0[0], v0[1]); w.y = cvt_pk_bf16(v0[2], v0[3]); w.z = cvt_pk_bf16(v1[0], v1[1]); w.w = cvt_pk_bf16(v1[2], v1[3]);
                    *(u32x4*)(P + PADDR(row, QA + col0 + bj * 128)) = w;
                }
            }
    }
};

DI int srccol(int dr) {
    if (dr < 2048) return dr;
    if (dr < 5120) return dr - 2048 + 3088;
    if (dr < 6144) return dr - 5120 + 2048;
    if (dr < 7168) return dr - 6144 + 6160;
    if (dr < 8192) return dr - 7168 + 7200;
    return dr - 8192 + 8224;
}
DI void transpose_tile(const Params& p, LAS unsigned char* lds, int tile) {
    const int tid = laundered_tid();
    unsigned char* ws = p.ws;
    LAS float* tl = (LAS float*)lds;
    const float* src; bf16_t* dst; int ldsrc, kt, scol0;
    if (tile < 2304) { const int nt = tile >> 4; kt = tile & 15; src = p.in[10]; ldsrc = 9248; dst = (bf16_t*)(ws + WS_W1) + (size_t)nt * 64 * 1024; scol0 = srccol(nt * 64); }
    else { int t2 = tile - 2304; const int w = t2 >> 8; t2 &= 255; const int nt = t2 >> 4; kt = t2 & 15; src = p.in[18 + w]; ldsrc = 1024;
        dst = (bf16_t*)(ws + (w == 0 ? WS_WPA : (w == 1 ? WS_WPB : WS_WOUT))) + (size_t)nt * 64 * 1024; scol0 = nt * 64; }
    { const int c = tid & 63, kr = tid >> 6;
#pragma unroll
      for (int i = 0; i < 8; ++i) { const int k = kr + 8 * i; tl[k * 65 + c] = src[(size_t)(kt * 64 + k) * ldsrc + scol0 + c]; } }
    __syncthreads();
    { const int k2 = (tid & 31) * 2, nb = tid >> 5;
#pragma unroll
      for (int i = 0; i < 4; ++i) { const int n = nb + 16 * i; *(unsigned*)(dst + (size_t)n * 1024 + kt * 64 + k2) = cvt_pk_bf16(tl[k2 * 65 + n], tl[(k2 + 1) * 65 + n]); } }
    __syncthreads();
}
DI void phase_prep(const Params& p, LAS unsigned char* lds) {
    const int tid = laundered_tid();
    unsigned char* ws = p.ws;
    for (int ti = blockIdx.x; ti < 1792; ti += gridDim.x) transpose_tile(p, lds, ti < 1280 ? ti : ti + 1024);
    { bf16_t* wsm = (bf16_t*)(ws + WS_WSM); const float* win = p.in[10];
      for (int idx = blockIdx.x * NTHR + tid; idx < 32 * 1024; idx += gridDim.x * NTHR) { const int n = idx >> 10, k = idx & 1023;
          const int sc = n < 16 ? 3072 + n : (n < 24 ? 7184 + (n - 16) : 7192 + (n - 24)); wsm[idx] = (bf16_t)f2bf(win[(size_t)k * 9248 + sc]); } }
    if (blockIdx.x < 192) {
        LAS float* sc = (LAS float*)lds;
        LAS float* red = (LAS float*)(lds + 65536);
        const float* cp = p.in[2]; const float* cs = p.in[3]; const float* wada = p.in[7]; const float* bada = p.in[8];
        float* mod = (float*)(ws + WS_MOD);
        for (int i = tid; i < 16384; i += NTHR) { const int r = i >> 10, k = i & 1023; const float c = r < 8 ? cp[r * 1024 + k] : cs[(r - 8) * 1024 + k]; sc[i] = siluf_(c); }
        __syncthreads();
        for (int item = blockIdx.x; item < 192; item += gridDim.x) {
            const int j0 = item * 16, cl = tid & 15, kk = tid >> 4;
            float acc[16];
#pragma unroll
            for (int r = 0; r < 16; ++r) acc[r] = 0.f;
#pragma unroll 8
            for (int k = kk; k < 1024; k += 32) { const float w = wada[(size_t)k * 3072 + j0 + cl];
#pragma unroll
                for (int r = 0; r < 16; ++r) acc[r] += sc[r * 1024 + k] * w; }
#pragma unroll
            for (int r = 0; r < 16; ++r) red[kk * 256 + r * 16 + cl] = acc[r];
            __syncthreads();
            if (tid < 256) { float s = 0.f;
#pragma unroll
                for (int q = 0; q < 32; ++q) s += red[q * 256 + tid];
                const int r = tid >> 4, c = tid & 15; mod[r * 3072 + j0 + c] = s + bada[j0 + c]; }
            __syncthreads();
        }
    }
}

DI void phase_h(const Params& p) {
    const int tid = laundered_tid(), lane = tid & 63, w = tid >> 6;
    const float* g1 = p.in[9];
    const float* mod = (const float*)(p.ws + WS_MOD);
    bf16_t* H = (bf16_t*)p.out;
    const int nrow = MP + 128, stride = gridDim.x * 8;
    for (int vr0 = blockIdx.x * 8 + w; vr0 < nrow; vr0 += 2 * stride) {
        f32x4 v[2][4]; float ss[2]; bf16_t* hp[2]; const float* mp[2]; bool on[2];
#pragma unroll
        for (int q = 0; q < 2; ++q) {
            const int vr = vr0 + q * stride; on[q] = vr < nrow;
            const float* x; int row, b;
            if (!on[q]) { x = p.in[0]; row = 0; b = 0; }
            else if (vr < MP) { x = p.in[0] + (size_t)vr * 1024; row = vr; b = vr >> 12; }
            else { const int k = vr - MP; x = p.in[1] + (size_t)k * 1024; row = MP + (k >> 4) * 64 + (k & 15); b = 8 + (k >> 4); }
            hp[q] = H + (size_t)row * 128; mp[q] = mod + (size_t)b * 3072;
            float sacc = 0.f;
#pragma unroll
            for (int i = 0; i < 4; ++i) { v[q][i] = *(const f32x4*)(x + i * 256 + lane * 4); sacc += (v[q][i][0] * v[q][i][0] + v[q][i][1] * v[q][i][1]) + (v[q][i][2] * v[q][i][2] + v[q][i][3] * v[q][i][3]); }
            ss[q] = sacc;
        }
#pragma unroll
        for (int q = 0; q < 2; ++q) {
            float sacc = row16_sum(ss[q]); sacc += __shfl_xor(sacc, 16); sacc += __shfl_xor(sacc, 32);
            const float rstd = rsqrtf(sacc * (1.0f / 1024.0f) + EPS);
            if (on[q]) {
#pragma unroll
                for (int i = 0; i < 4; ++i) { const int c = i * 256 + lane * 4;
                    const f32x4 g = *(const f32x4*)(g1 + c), sc = *(const f32x4*)(mp[q] + 1024 + c), sh = *(const f32x4*)(mp[q] + c);
                    const f32x4 y = v[q][i] * rstd * g * (sc + 1.0f) + sh;
                    u32x2 o; o.x = cvt_pk_bf16(y[0], y[1]); o.y = cvt_pk_bf16(y[2], y[3]); *(u32x2*)(hp[q] + (size_t)(c >> 7) * MT * 128 + (c & 127)) = o; }
            }
        }
    }
}

DI void phase_small(const Params& p) {
    const int tid = laundered_tid(), lane = tid & 63, w = tid >> 6;
    const bf16_t* H = (const bf16_t*)p.out; const bf16_t* W = (const bf16_t*)(p.ws + WS_WSM);
    float* PS = (float*)(p.ws + WS_PS);
    for (int it = blockIdx.x * 8 + w; it < MP / 16 + 8; it += gridDim.x * 8) {
        const int row0 = it < MP / 16 ? it * 16 : MP + (it - MP / 16) * 64;
        const bf16_t* ap = H + (size_t)(row0 + (lane & 15)) * 128 + (lane >> 4) * 8;
        const bf16_t* bp = W + (size_t)(lane & 15) * 1024 + (lane >> 4) * 8;
        f32x4 a0 = {0.f, 0.f, 0.f, 0.f}, a1 = {0.f, 0.f, 0.f, 0.f};
#pragma unroll 8
        for (int k = 0; k < 1024; k += 32) { const bf16x8 a = *(const bf16x8*)(ap + (size_t)(k >> 7) * MT * 128 + (k & 127));
            a0 = MFMA16(a, *(const bf16x8*)(bp + k), a0); a1 = MFMA16(a, *(const bf16x8*)(bp + 16 * 1024 + k), a1); }
#pragma unroll
        for (int r = 0; r < 4; ++r) { float* o = PS + (size_t)(row0 + (lane >> 4) * 4 + r) * 32 + (lane & 15); o[0] = a0[r]; o[16] = a1[r]; }
    }
}


template <class F>
DI void gemm_small(const bf16_t* A, int lda, size_t wstep, const bf16_t* Bt, int N, const F& epi) {
    const int tid = laundered_tid(), lane = tid & 63, w = tid >> 6;
    const int ntask = 8 * (N / 32);
    for (int task = blockIdx.x * 8 + w; task < ntask; task += gridDim.x * 8) {
        const int s = task & 7, n0 = (task >> 3) * 32, rowbase = MP + s * 64;
        const bf16_t* ap = A + (size_t)(rowbase + (lane & 15)) * lda + (lane >> 4) * 8;
        const bf16_t* bp = Bt + (size_t)(n0 + (lane & 15)) * 1024 + (lane >> 4) * 8;
        f32x4 a0 = {0.f, 0.f, 0.f, 0.f}, a1 = {0.f, 0.f, 0.f, 0.f};
#pragma unroll 2
        for (int kw = 0; kw < 8; ++kw) {
#pragma unroll
            for (int kk = 0; kk < 4; ++kk) { const int k = kw * 128 + kk * 32; const bf16x8 a = *(const bf16x8*)(ap + kw * wstep + kk * 32);
                a0 = MFMA16(a, *(const bf16x8*)(bp + k), a0); a1 = MFMA16(a, *(const bf16x8*)(bp + 16 * 1024 + k), a1); } }
        epi(rowbase + (lane >> 4) * 4, n0 + (lane & 15), a0, a1, lane);
    }
}
struct SEpiG1 { bf16_t* P; float* convs;
    DI void operator()(int row, int col, const f32x4& a0, const f32x4& a1, int) const {
#pragma unroll
        for (int r = 0; r < 4; ++r) { const int rw = row + r, rl = rw & 63;
#pragma unroll
            for (int q = 0; q < 2; ++q) { const int cc = col + q * 16; const float v = q ? a1[r] : a0[r];
                P[PADDR(rw, cc)] = (bf16_t)f2bf(v);
                if (cc >= 2048 && rl >= 13) convs[((size_t)((rw - MP) >> 6) * 3 + (rl - 13)) * 3072 + (cc - 2048)] = v; } }
    } };
struct SEpiG1b { bf16_t* P; const float* ssa; const float* ssb; const float* gna; const float* gnb;
    DI void operator()(int row, int col, const f32x4& a0, const f32x4& a1, int) const {
        const int kind = col >> 10;
#pragma unroll
        for (int r = 0; r < 4; ++r) { const int rw = row + r;
#pragma unroll
            for (int q = 0; q < 2; ++q) { const int cc = (col & 1023) + q * 16; const float v = q ? a1[r] : a0[r];
                if (kind == 0) { const int head = cc >> 8; const float* sp = ssa + (size_t)rw * 32 + head * 8; float ss = 0.f;
#pragma unroll
                    for (int e = 0; e < 8; ++e) ss += sp[e];
                    bf16_t* d = P + PADDR(rw, VA + cc); *d = (bf16_t)f2bf(bf2f(*d) * rsqrtf(ss * (1.0f / 256.0f) + EPS) * gna[cc & 255] * fsilu(v)); }
                else if (kind == 1) { const int head = cc >> 7; const float* sp = ssb + (size_t)rw * 32 + head * 4; const float ss = (sp[0] + sp[1]) + (sp[2] + sp[3]);
                    bf16_t* d = P + PADDR(rw, GV + cc); *d = (bf16_t)f2bf(bf2f(*d) * rsqrtf(ss * (1.0f / 128.0f) + EPS) * gnb[cc & 127] * fsilu(v)); }
                else P[PADDR(rw, (kind == 2 ? QA : GQ) + cc)] = (bf16_t)f2bf(__builtin_amdgcn_rcpf(1.0f + __expf(-v))); } }
    } };
template <int SECOND>
struct SEpiMerge { bf16_t* P;
    DI void operator()(int row, int col, const f32x4& a0, const f32x4& a1, int) const {
#pragma unroll
        for (int r = 0; r < 4; ++r) { const int rw = row + r;
#pragma unroll
            for (int q = 0; q < 2; ++q) { const int cc = col + q * 16; const float v = q ? a1[r] : a0[r];
                const float sg = bf2f(P[PADDR(rw, (SECOND ? GQ : QA) + cc)]); bf16_t* d = P + PADDR(rw, GK + cc);
                *d = (bf16_t)f2bf(SECOND ? bf2f(*d) + sg * v : sg * v); } }
    } };
struct SEpiOut { bf16_t* P;
    DI void operator()(int row, int col, const f32x4& a0, const f32x4& a1, int) const {
#pragma unroll
        for (int r = 0; r < 4; ++r) { P[PADDR((row + r), QA + col)] = (bf16_t)f2bf(a0[r]); P[PADDR((row + r), QA + col + 16)] = (bf16_t)f2bf(a1[r]); }
    } };

template <bool DRY>
DI void gla1_item(const Params& p, LAS unsigned char* lds, int item, unsigned (&qn)[16], unsigned (&kn)[16], bool& have, int next) {
    const int tid = laundered_tid(), lane = tid & 63, w = tid >> 6;
    const int c = item >> 2, h = item & 3, r0 = c * 64, valid = c < 512 ? 64 : 16;
    LAS bf16_t* Qt = (LAS bf16_t*)lds;
    LAS bf16_t* Kt = Qt + 64 * 136;
    LAS float* gl = (LAS float*)(lds + 34816);
    LAS float* tot = (LAS float*)(lds + 34816 + 4096);
    bf16_t* P = (bf16_t*)(p.ws + WS_P); const float* PS = (const float*)(p.ws + WS_PS);
    bf16_t* ATT = (bf16_t*)(p.ws + WS_ATT); float* GDEC = (float*)(p.ws + WS_GDEC);
    const int dk = tid & 127, rg = tid >> 7;
    bf16_t* qp = P + PADDR((r0 + rg * 16), QA + h * 128 + dk); const bf16_t* kp = P + PADDR((r0 + rg * 16), KA + h * 128 + dk);
    unsigned qraw[16], kraw[16];
    if (have) {
#pragma unroll
        for (int i = 0; i < 16; ++i) { qraw[i] = qn[i]; kraw[i] = kn[i]; }
    } else {
#pragma unroll
        for (int i = 0; i < 16; ++i) { qraw[i] = qp[(size_t)i * PRS]; kraw[i] = kp[(size_t)i * PRS]; }
    }
    if (tid < 256) { const int row = tid >> 2, q4 = tid & 3; *(LAS f32x4*)(gl + row * 16 + q4 * 4) = *(const f32x4*)(PS + (size_t)(r0 + row) * 32 + q4 * 4); }
    float wv[16];
#pragma unroll
    for (int r = 0; r < 16; ++r) wv[r] = p.in[11][r * 512 + h * 128 + dk];
    const float bias = p.in[12][h * 128 + dk];
    __syncthreads();
    float bb[16]; float run = 0.f;
#pragma unroll
    for (int i = 0; i < 16; ++i) { const int row = rg * 16 + i; float z = bias;
#pragma unroll
        for (int r = 0; r < 16; ++r) z += gl[row * 16 + r] * wv[r];
        const float ls = fminf(z, 0.f) - 0.6931471805599453f * __builtin_amdgcn_logf(1.0f + __expf(-fabsf(z)));
        const float g = row < valid ? ls * (1.0f / 16.0f) : 0.f; run += g; bb[i] = run; }
    tot[rg * 128 + dk] = run;
    asm volatile("s_waitcnt vmcnt(0)" ::: "memory");
    __syncthreads();
    const float t0 = tot[dk], t1 = tot[128 + dk], t2 = tot[256 + dk], t3 = tot[384 + dk];
    const float off = rg == 0 ? 0.f : (rg == 1 ? t0 : (rg == 2 ? t0 + t1 : t0 + t1 + t2));
    const float bref = t0 + t1, blast = (t0 + t1) + (t2 + t3);
    float kd[16];
#pragma unroll
    for (int i = 0; i < 16; ++i) { const int row = rg * 16 + i; const float b = bb[i] + off;
        const float qv = row < valid ? bf2f(qraw[i]) * 0.08838834764831845f : 0.f;
        const float kv = row < valid ? bf2f(kraw[i]) : 0.f;
        Qt[row * 136 + dk] = (bf16_t)f2bf(qv * __expf(b - bref)); Kt[row * 136 + dk] = (bf16_t)f2bf(kv * __expf(bref - b));
        if (!DRY) qp[(size_t)i * PRS] = (bf16_t)f2bf(qv * __expf(b));
        kd[i] = kv * __expf(blast - b); }
    if (rg == 0) GDEC[item * 128 + dk] = __expf(blast);
    have = next < NCH * 4;
    if (have) { const int cn = next >> 2, hn = next & 3;
        const bf16_t* qpn = P + PADDR((cn * 64 + rg * 16), QA + hn * 128 + dk); const bf16_t* kpn = P + PADDR((cn * 64 + rg * 16), KA + hn * 128 + dk);
#pragma unroll
        for (int i = 0; i < 16; ++i) { qn[i] = qpn[(size_t)i * PRS]; kn[i] = kpn[(size_t)i * PRS]; } }
    __syncthreads();
    { u32x4 w0, w1; w0.x = cvt_pk_bf16(kd[0], kd[1]); w0.y = cvt_pk_bf16(kd[2], kd[3]); w0.z = cvt_pk_bf16(kd[4], kd[5]); w0.w = cvt_pk_bf16(kd[6], kd[7]);
      w1.x = cvt_pk_bf16(kd[8], kd[9]); w1.y = cvt_pk_bf16(kd[10], kd[11]); w1.z = cvt_pk_bf16(kd[12], kd[13]); w1.w = cvt_pk_bf16(kd[14], kd[15]);
      bf16_t* d = P + PADDR((r0 + (dk >> 1)), KA + h * 128 + (dk & 1) * 64 + rg * 16); if (!DRY) { *(u32x4*)d = w0; *(u32x4*)(d + 8) = w1; } }
#pragma unroll
    for (int tt = 0; tt < 2; ++tt) { const int idx = w * 2 + tt, mt = idx >> 2, nt = idx & 3;
        f32x4 acc = {0.f, 0.f, 0.f, 0.f};
        if (mt <= nt) acc = mma16<128>(acc, Kt + mt * 16 * 136, 136, Qt + nt * 16 * 136, 136, lane);
        const int j0 = mt * 16 + (lane >> 4) * 4, i = nt * 16 + (lane & 15);
        u32x2 o; o.x = cvt_pk_bf16(j0 <= i ? acc[0] : 0.f, j0 + 1 <= i ? acc[1] : 0.f); o.y = cvt_pk_bf16(j0 + 2 <= i ? acc[2] : 0.f, j0 + 3 <= i ? acc[3] : 0.f);
        *(u32x2*)(ATT + (size_t)item * 4096 + i * 64 + j0) = o; }
    __syncthreads();
}

template <bool DRY>
DI void gdn1_item(const Params& p, LAS unsigned char* lds, int item, f32x2 (&wreg)[16], int& wh, u32x4 (&rawn)[11], bool& have, int next, float (&psn)[2], bool& havep) {
    const int tid = laundered_tid(), lane = tid & 63, w = __builtin_amdgcn_readfirstlane(tid >> 6);
    const int c = item >> 3, h = item & 7, r0 = c * 64, valid = c < 512 ? 64 : 16;
    LAS bf16_t* Kimg = (LAS bf16_t*)lds;
    LAS bf16_t* Qimg = Kimg + 64 * 136;
    LAS bf16_t* KD = Qimg + 64 * 136;
    LAS bf16_t* XT = (LAS bf16_t*)lds;
    LAS float* R = (LAS float*)(lds + 52224);
    LAS bf16_t* NA = (LAS bf16_t*)(lds + 118784);
    LAS float* AD = (LAS float*)(lds + 128000);
    LAS bf16_t* TI = (LAS bf16_t*)(lds + 132096);
    LAS float* gsh = (LAS float*)(lds + 133632);
    LAS float* besh = gsh + 64; LAS float* bsh = besh + 64;
    bf16_t* P = (bf16_t*)(p.ws + WS_P); const float* PS = (const float*)(p.ws + WS_PS);
    const bf16_t* halo = (const bf16_t*)(p.ws + WS_HALO);
    bf16_t* WK = (bf16_t*)(p.ws + WS_WK); bf16_t* QKb = (bf16_t*)(p.ws + WS_QK); float* BDEC = (float*)(p.ws + WS_BDEC);
    const float* wconv = p.in[13]; const float* cache = p.in[6];
    const int X = w >> 1;
    const int t7 = tid & 127, cg = t7 & 15, rseg = t7 >> 4;
    const int cb = X * 1024 + h * 128 + cg * 8;
    f32x2 f[11][4];
    if (w < 6) {
        if (wh != h) {
#pragma unroll
            for (int i = 0; i < 4; ++i) { const f32x4 a = *(const f32x4*)(wconv + (size_t)i * 3072 + cb), b = *(const f32x4*)(wconv + (size_t)i * 3072 + cb + 4);
                wreg[i * 4 + 0] = (f32x2){a[0], a[1]}; wreg[i * 4 + 1] = (f32x2){a[2], a[3]}; wreg[i * 4 + 2] = (f32x2){b[0], b[1]}; wreg[i * 4 + 3] = (f32x2){b[2], b[3]}; }
        }
        if (have) {
#pragma unroll
            for (int i = 0; i < 11; ++i) { const u32x4 a = rawn[i];
                f[i][0] = (f32x2){bflo(a.x), bfhi(a.x)}; f[i][1] = (f32x2){bflo(a.y), bfhi(a.y)}; f[i][2] = (f32x2){bflo(a.z), bfhi(a.z)}; f[i][3] = (f32x2){bflo(a.w), bfhi(a.w)}; }
        } else {
#pragma unroll
        for (int i = 0; i < 11; ++i) {
            const int rr = rseg * 8 - 3 + i;
            if (rr >= 0) { const u32x4 a = *(const u32x4*)(P + PADDR((r0 + rr), GQ + cb));
                f[i][0] = (f32x2){bflo(a.x), bfhi(a.x)}; f[i][1] = (f32x2){bflo(a.y), bfhi(a.y)}; f[i][2] = (f32x2){bflo(a.z), bfhi(a.z)}; f[i][3] = (f32x2){bflo(a.w), bfhi(a.w)}; }
            else if (c >= 512) { const float* sp = cache + ((size_t)(c - 512) * 3 + (3 + rr)) * 3072 + cb; const f32x4 a = *(const f32x4*)sp, b = *(const f32x4*)(sp + 4);
                f[i][0] = (f32x2){a[0], a[1]}; f[i][1] = (f32x2){a[2], a[3]}; f[i][2] = (f32x2){b[0], b[1]}; f[i][3] = (f32x2){b[2], b[3]}; }
            else if ((c & 63) == 0) {
#pragma unroll
                for (int e = 0; e < 4; ++e) f[i][e] = (f32x2){0.f, 0.f}; }
            else { const u32x4 a = *(const u32x4*)(halo + ((size_t)(c - 1) * 3 + (3 + rr)) * 3072 + cb);
                f[i][0] = (f32x2){bflo(a.x), bfhi(a.x)}; f[i][1] = (f32x2){bflo(a.y), bfhi(a.y)}; f[i][2] = (f32x2){bflo(a.z), bfhi(a.z)}; f[i][3] = (f32x2){bflo(a.w), bfhi(a.w)}; }
        }
        }
    } else if (w == 6) {
        const int row = lane; const bool rvalid = row < valid;
        const float bin = havep ? psn[0] : PS[(size_t)(r0 + row) * 32 + 16 + h], ain = havep ? psn[1] : PS[(size_t)(r0 + row) * 32 + 24 + h];
        const float be = rvalid ? __builtin_amdgcn_rcpf(1.0f + __expf(-bin)) : 0.f;
        float x = rvalid ? -__expf(p.in[14][h]) * softplusf_(ain + p.in[15][h]) : 0.f;
#pragma unroll
        for (int off = 1; off < 64; off <<= 1) { const float y = __shfl_up(x, off); if (lane >= off) x += y; }
        bsh[lane] = x; besh[lane] = be;
        if (lane == 63) BDEC[item] = __expf(x);
    }
    wh = h;
    asm volatile("s_waitcnt vmcnt(0)" ::: "memory");
    __syncthreads();
    if (w < 6) {
        const float bl = bsh[63];
#pragma unroll
        for (int o = 0; o < 8; ++o) {
            const int row = rseg * 8 + o; const bool rvalid = row < valid;
            float v[8];
#pragma unroll
            for (int e = 0; e < 4; ++e) { f32x2 a = f[o][e] * wreg[e];
                a = __builtin_elementwise_fma(f[o + 1][e], wreg[4 + e], a); a = __builtin_elementwise_fma(f[o + 2][e], wreg[8 + e], a); a = __builtin_elementwise_fma(f[o + 3][e], wreg[12 + e], a);
                v[2 * e] = rvalid ? fsilu(a.x) : 0.f; v[2 * e + 1] = rvalid ? fsilu(a.y) : 0.f; }
            const float bi = bsh[row], be = besh[row];
            if (X < 2) {
                float ss = 0.f;
#pragma unroll
                for (int e = 0; e < 8; ++e) ss += v[e] * v[e];
                ss = row16_sum(ss);
                const float rn = rsqrtf(ss + EPS) * (X == 0 ? 0.08838834764831845f : 1.0f);
#pragma unroll
                for (int e = 0; e < 8; ++e) v[e] *= rn;
                u32x4 o0; o0.x = cvt_pk_bf16(v[0], v[1]); o0.y = cvt_pk_bf16(v[2], v[3]); o0.z = cvt_pk_bf16(v[4], v[5]); o0.w = cvt_pk_bf16(v[6], v[7]);
                if (X == 0) {
                    *(LAS u32x4*)(Qimg + row * 136 + cg * 8) = o0;
                    const float eb = __expf(bi);
                    u32x4 o1; o1.x = cvt_pk_bf16(v[0] * eb, v[1] * eb); o1.y = cvt_pk_bf16(v[2] * eb, v[3] * eb); o1.z = cvt_pk_bf16(v[4] * eb, v[5] * eb); o1.w = cvt_pk_bf16(v[6] * eb, v[7] * eb);
                    if (!DRY) *(u32x4*)(P + PADDR((r0 + row), GQ + h * 128 + cg * 8)) = o1;
                } else {
                    *(LAS u32x4*)(Kimg + row * 136 + cg * 8) = o0;
                    const float ekd = __expf(bl - bi), bek = be * __expf(bi);
                    u32x4 o1; o1.x = cvt_pk_bf16(v[0] * ekd, v[1] * ekd); o1.y = cvt_pk_bf16(v[2] * ekd, v[3] * ekd); o1.z = cvt_pk_bf16(v[4] * ekd, v[5] * ekd); o1.w = cvt_pk_bf16(v[6] * ekd, v[7] * ekd);
                    *(LAS u32x4*)(KD + row * 136 + cg * 8) = o1;
                    f32x4 a, b;
#pragma unroll
                    for (int e = 0; e < 4; ++e) { a[e] = bek * v[e]; b[e] = bek * v[4 + e]; }
                    *(LAS f32x4*)(R + row * 260 + 128 + cg * 8) = a; *(LAS f32x4*)(R + row * 260 + 128 + cg * 8 + 4) = b;
                }
            } else {
                f32x4 a, b;
#pragma unroll
                for (int e = 0; e < 4; ++e) { a[e] = be * v[e]; b[e] = be * v[4 + e]; }
                *(LAS f32x4*)(R + row * 260 + cg * 8) = a; *(LAS f32x4*)(R + row * 260 + cg * 8 + 4) = b;
            }
        }
    }
    {
        const int cn = next >> 3, hn = next & 7;
        havep = next < NCH * 8;
        if (havep && w == 6) { psn[0] = PS[(size_t)(cn * 64 + lane) * 32 + 16 + hn]; psn[1] = PS[(size_t)(cn * 64 + lane) * 32 + 24 + hn]; }
        have = next < NCH * 8 && cn < 512;
        if (have && w < 6) {
            const int cbn = X * 1024 + hn * 128 + cg * 8; const u32x4 z = {0u, 0u, 0u, 0u};
#pragma unroll
            for (int i = 0; i < 11; ++i) { const int rr = rseg * 8 - 3 + i;
                if (rr >= 0) rawn[i] = *(const u32x4*)(P + PADDR((cn * 64 + rr), GQ + cbn));
                else if ((cn & 63) == 0) rawn[i] = z;
                else rawn[i] = *(const u32x4*)(halo + ((size_t)(cn - 1) * 3 + (3 + rr)) * 3072 + cbn); }
        }
    }
    __syncthreads();
#pragma unroll
    for (int tt = 0; tt < 2; ++tt) { const int idx = w * 2 + tt, mt = idx >> 2, nt = idx & 3;
        f32x4 acc = {0.f, 0.f, 0.f, 0.f};
        if (nt <= mt) acc = mma16<128>(acc, Kimg + mt * 16 * 136, 136, Kimg + nt * 16 * 136, 136, lane);
        const int i0 = mt * 16 + (lane >> 4) * 4, j = nt * 16 + (lane & 15); const float bj = bsh[j];
#pragma unroll
        for (int r = 0; r < 4; ++r) { const int i = i0 + r; const float a = j < i ? besh[i] * acc[r] * __expf(fminf(bsh[i] - bj, 0.f)) : 0.f;
            NA[i * 72 + j] = (bf16_t)f2bf(nt < mt ? -a : 0.f);
            if (nt == mt) AD[(mt * 16 + (i & 15)) * 16 + (j & 15)] = a; } }
#pragma unroll
    for (int tt = 0; tt < 2; ++tt) { const int idx = w * 2 + tt, mt = idx >> 2, nt = idx & 3;
        f32x4 acc = {0.f, 0.f, 0.f, 0.f};
        if (mt <= nt) acc = mma16<128>(acc, Kimg + mt * 16 * 136, 136, Qimg + nt * 16 * 136, 136, lane);
        const int j0 = mt * 16 + (lane >> 4) * 4, i = nt * 16 + (lane & 15); const float bi = bsh[i];
        float v[4];
#pragma unroll
        for (int r = 0; r < 4; ++r) v[r] = (j0 + r <= i) ? acc[r] * __expf(fminf(bi - bsh[j0 + r], 0.f)) : 0.f;
        u32x2 o; o.x = cvt_pk_bf16(v[0], v[1]); o.y = cvt_pk_bf16(v[2], v[3]);
        *(u32x2*)(QKb + (size_t)item * 4096 + i * 64 + j0) = o; }
    {
        const int dk = tid & 127, tq = tid >> 7;
        unsigned wv[8];
#pragma unroll
        for (int e = 0; e < 8; ++e) { const unsigned lo = KD[(tq * 16 + 2 * e) * 136 + dk], hi = KD[(tq * 16 + 2 * e + 1) * 136 + dk]; wv[e] = lo | (hi << 16); }
        bf16_t* d = P + PADDR((r0 + (dk >> 1)), GK + h * 128 + (dk & 1) * 64 + tq * 16);
        u32x4 o0, o1; o0.x = wv[0]; o0.y = wv[1]; o0.z = wv[2]; o0.w = wv[3]; o1.x = wv[4]; o1.y = wv[5]; o1.z = wv[6]; o1.w = wv[7];
        if (!DRY) { *(u32x4*)d = o0; *(u32x4*)(d + 8) = o1; }
    }
    __syncthreads();
    if (w == 0) {
        const int blk = lane >> 4, cc = lane & 15;
        const LAS float* A = AD + blk * 256;
        float t[16];
#pragma unroll
        for (int i = 0; i < 16; ++i) { float sacc = (i == cc) ? 1.0f : 0.0f;
#pragma unroll
            for (int j = 0; j < i; ++j) sacc -= A[i * 16 + j] * t[j];
            t[i] = sacc; TI[(blk * 16 + i) * 24 + cc] = (bf16_t)f2bf(sacc); }
    }
    __syncthreads();
    {
        const int g4 = (lane >> 4) * 4, m = lane & 15;
#pragma unroll
        for (int tt = 0; tt < 2; ++tt) {
            const int n0 = (w * 2 + tt) * 16;
            { const u32x4 z = {0u, 0u, 0u, 0u}; *(LAS u32x4*)(XT + (n0 + m) * 72 + g4 * 4) = z; *(LAS u32x4*)(XT + (n0 + m) * 72 + g4 * 4 + 8) = z; }
#pragma unroll
            for (int r = 0; r < 4; ++r) {
                f32x4 acc;
#pragma unroll
                for (int e = 0; e < 4; ++e) acc[e] = R[(r * 16 + g4 + e) * 260 + n0 + m];
                if (r > 0) acc = mma16<64>(acc, NA + r * 16 * 72, 72, XT + n0 * 72, 72, lane);
                u32x4 bw; bw.x = cvt_pk_bf16(acc[0], acc[1]); bw.y = cvt_pk_bf16(acc[2], acc[3]); bw.z = 0u; bw.w = 0u;
                const u32x2 tv = *(const LAS u32x2*)(TI + (r * 16 + m) * 24 + g4);
                u32x4 aw; aw.x = tv.x; aw.y = tv.y; aw.z = 0u; aw.w = 0u;
                f32x4 x = {0.f, 0.f, 0.f, 0.f};
                x = MFMA16(__builtin_bit_cast(bf16x8, aw), __builtin_bit_cast(bf16x8, bw), x);
                u32x2 o; o.x = cvt_pk_bf16(x[0], x[1]); o.y = cvt_pk_bf16(x[2], x[3]);
                *(LAS u32x2*)(XT + (n0 + m) * 72 + r * 16 + g4) = o;
            }
        }
    }
    __syncthreads();
#pragma unroll
    for (int l = 0; l < 2; ++l) { const int idx = tid + l * 512;
        {
            const int cc = idx >> 3, t8 = (idx & 7) * 8; const u32x4 v = *(const LAS u32x4*)(XT + cc * 72 + t8);
            if (!DRY) *(u32x4*)(P + PADDR((r0 + (cc & 63)), GV + h * 128 + (cc >> 6) * 64 + t8)) = v; }
        {
            const int tok = idx & 63, d8 = (idx >> 6) * 8; unsigned wv[4];
#pragma unroll
            for (int e = 0; e < 4; ++e) { const unsigned lo = XT[(128 + d8 + 2 * e) * 72 + tok], hi = XT[(128 + d8 + 2 * e + 1) * 72 + tok]; wv[e] = lo | (hi << 16); }
            u32x4 o; o.x = wv[0]; o.y = wv[1]; o.z = wv[2]; o.w = wv[3];
            *(u32x4*)(WK + (size_t)item * 8192 + tok * 128 + d8) = o; }
    }
    __syncthreads();
}

template <bool DRY>
DI void gla2_item(const Params& p, LAS unsigned char* lds, int item) {
    const int tid = laundered_tid(), lane = tid & 63, w = __builtin_amdgcn_readfirstlane(tid >> 6);
    const bool sample = item >= 128; const int it = item & 127;
    const int sq = it >> 4, h = (it >> 2) & 3, j4 = it & 3, dv0 = j4 * 64;
    const int c0 = sample ? 512 + sq : sq * 64, nch = sample ? 1 : 64, valid = sample ? 16 : 64;
    bf16_t* P = (bf16_t*)(p.ws + WS_P); const bf16_t* ATT = (const bf16_t*)(p.ws + WS_ATT); const float* GDEC = (const float*)(p.ws + WS_GDEC);
    float* SSA = (float*)(p.ws + WS_SSA);
    f32x4 Sacc[4];
    const int sdk = w * 16 + (lane >> 4) * 4;
#pragma unroll
    for (int nt = 0; nt < 4; ++nt) {
#pragma unroll
        for (int r = 0; r < 4; ++r) Sacc[nt][r] = sample ? p.in[4][((size_t)(sq * 4 + h) * 128 + sdk + r) * 256 + dv0 + nt * 16 + (lane & 15)] : 0.f;
    }
    struct RS { u32x4 ra, rq[2], rk[2], rv; float rd; };
    RS RA, RB; RA.rd = 0.f; RB.rd = 0.f;
    auto load = [&](int c, RS& R) {
        const int r0 = c * 64, ia = c * 4 + h;
        R.ra = *(const u32x4*)(ATT + (size_t)ia * 4096 + tid * 8);
#pragma unroll
        for (int l = 0; l < 2; ++l) { const int idx = tid + l * 512;
            { const int i = idx >> 4, d8 = (idx & 15) * 8; R.rq[l] = *(const u32x4*)(P + PADDR((r0 + i), QA + h * 128 + d8)); }
            { const int dk = idx >> 3, t8 = (idx & 7) * 8; R.rk[l] = *(const u32x4*)(P + PADDR((r0 + (dk >> 1)), KA + h * 128 + (dk & 1) * 64 + t8)); } }
        { const int tok = tid >> 3, e8 = (tid & 7) * 8; const u32x4 z = {0u, 0u, 0u, 0u};
          R.rv = tok < valid ? *(const u32x4*)(P + PADDR((r0 + tok), VA + h * 256 + dv0 + e8)) : z; }
        if (tid < 128) R.rd = GDEC[ia * 128 + tid];
    };
    auto store = [&](int b, const RS& R) {
        LAS unsigned char* base = lds + b * 54272;
        LAS bf16_t* att = (LAS bf16_t*)base; LAS bf16_t* qd = (LAS bf16_t*)(base + 9216); LAS bf16_t* kT = (LAS bf16_t*)(base + 26624); LAS bf16_t* vT = (LAS bf16_t*)(base + 45056);
        *(LAS u32x4*)(att + (tid >> 3) * 72 + (tid & 7) * 8) = R.ra;
#pragma unroll
        for (int l = 0; l < 2; ++l) { const int idx = tid + l * 512;
            *(LAS u32x4*)(qd + (idx >> 4) * 136 + (idx & 15) * 8) = R.rq[l];
            *(LAS u32x4*)(kT + (idx >> 3) * 72 + (idx & 7) * 8) = R.rk[l]; }
        { const int tok = tid >> 3, e8 = (tid & 7) * 8; const unsigned vv[4] = {R.rv.x, R.rv.y, R.rv.z, R.rv.w};
#pragma unroll
          for (int e = 0; e < 8; ++e) vT[(e8 + e) * 72 + tok] = (bf16_t)((vv[e >> 1] >> (16 * (e & 1))) & 0xffffu); }
        if (tid < 128) ((LAS float*)(lds + 143360 + b * 512))[tid] = R.rd;
    };
    auto writeST = [&](int b) {
        LAS bf16_t* ST = (LAS bf16_t*)(lds + 108544 + b * 17408);
#pragma unroll
        for (int nt = 0; nt < 4; ++nt) { u32x2 o; o.x = cvt_pk_bf16(Sacc[nt][0], Sacc[nt][1]); o.y = cvt_pk_bf16(Sacc[nt][2], Sacc[nt][3]);
            *(LAS u32x2*)(ST + (nt * 16 + (lane & 15)) * 136 + sdk) = o; }
    };
    load(c0, RA); store(0, RA); writeST(0);
    if (nch > 1) load(c0 + 1, RB);
    __syncthreads();
    auto step = [&](int n, RS& Rl, const RS& Rs) {
        const int cur = n & 1, r0 = (c0 + n) * 64;
        if (n + 2 < nch) load(c0 + n + 2, Rl);
        LAS unsigned char* base = lds + cur * 54272;
        const LAS bf16_t* att = (const LAS bf16_t*)base; const LAS bf16_t* qd = (const LAS bf16_t*)(base + 9216);
        const LAS bf16_t* kT = (const LAS bf16_t*)(base + 26624); const LAS bf16_t* vT = (const LAS bf16_t*)(base + 45056);
        const LAS bf16_t* ST = (const LAS bf16_t*)(lds + 108544 + cur * 17408);
        const LAS float* dec = (const LAS float*)(lds + 143360 + cur * 512);
        {
            const int mt = w >> 1, nt0 = (w & 1) * 2; float ssq[4] = {0.f, 0.f, 0.f, 0.f};
            const int tok0 = mt * 16 + (lane >> 4) * 4;
            bf16x8 aa[2], aqd[4], bv[2][2], bs[2][4];
#pragma unroll
            for (int k2 = 0; k2 < 2; ++k2) { aa[k2] = ldfrag(att + mt * 16 * 72, 72, lane, k2 * 32); bv[0][k2] = ldfrag(vT + nt0 * 16 * 72, 72, lane, k2 * 32); bv[1][k2] = ldfrag(vT + (nt0 + 1) * 16 * 72, 72, lane, k2 * 32); }
#pragma unroll
            for (int k4 = 0; k4 < 4; ++k4) { aqd[k4] = ldfrag(qd + mt * 16 * 136, 136, lane, k4 * 32); bs[0][k4] = ldfrag(ST + nt0 * 16 * 136, 136, lane, k4 * 32); bs[1][k4] = ldfrag(ST + (nt0 + 1) * 16 * 136, 136, lane, k4 * 32); }
            __builtin_amdgcn_sched_barrier(0);
            f32x4 acc[2] = {{0.f, 0.f, 0.f, 0.f}, {0.f, 0.f, 0.f, 0.f}};
#pragma unroll
            for (int k2 = 0; k2 < 2; ++k2) { acc[0] = MFMA16(aa[k2], bv[0][k2], acc[0]); acc[1] = MFMA16(aa[k2], bv[1][k2], acc[1]); }
#pragma unroll
            for (int k4 = 0; k4 < 4; ++k4) { acc[0] = MFMA16(aqd[k4], bs[0][k4], acc[0]); acc[1] = MFMA16(aqd[k4], bs[1][k4], acc[1]); }
#pragma unroll
            for (int tt = 0; tt < 2; ++tt) {
                bf16_t* d = P + PADDR((r0 + tok0), VA + h * 256 + dv0 + (nt0 + tt) * 16 + (lane & 15));
#pragma unroll
                for (int r = 0; r < 4; ++r) { if (!DRY) d[(size_t)r * PRS] = (bf16_t)f2bf(acc[tt][r]); ssq[r] += acc[tt][r] * acc[tt][r]; } }
#pragma unroll
            for (int r = 0; r < 4; ++r) { const float s = row16_sum(ssq[r]);
                if ((lane & 15) == 0) SSA[(size_t)(r0 + tok0 + r) * 32 + h * 8 + j4 * 2 + (w & 1)] = s; }
        }
        {
            const f32x4 dv = *(const LAS f32x4*)(dec + sdk);
            bf16x8 ak[2], bv[4][2];
#pragma unroll
            for (int k2 = 0; k2 < 2; ++k2) { ak[k2] = ldfrag(kT + w * 16 * 72, 72, lane, k2 * 32);
#pragma unroll
                for (int nt = 0; nt < 4; ++nt) bv[nt][k2] = ldfrag(vT + nt * 16 * 72, 72, lane, k2 * 32); }
            __builtin_amdgcn_sched_barrier(0);
#pragma unroll
            for (int nt = 0; nt < 4; ++nt) Sacc[nt] = Sacc[nt] * dv;
#pragma unroll
            for (int k2 = 0; k2 < 2; ++k2)
#pragma unroll
                for (int nt = 0; nt < 4; ++nt) Sacc[nt] = MFMA16(ak[k2], bv[nt][k2], Sacc[nt]);
            writeST(cur ^ 1);
        }
        if (n + 1 < nch) store(cur ^ 1, Rs);
        __syncthreads();
    };
    for (int n = 0; n < nch; n += 2) { step(n, RA, RB); if (n + 1 < nch) step(n + 1, RB, RA); }
    float* so = p.out + (sample ? O_SGLAS : O_SGLAP);
#pragma unroll
    for (int nt = 0; nt < 4; ++nt)
#pragma unroll
        for (int r = 0; r < 4; ++r) so[((size_t)(sq * 4 + h) * 128 + sdk + r) * 256 + dv0 + nt * 16 + (lane & 15)] = Sacc[nt][r];
    __syncthreads();
}

template <bool DRY>
DI void gdn2_item(const Params& p, LAS unsigned char* lds, int item) {
    const int tid = laundered_tid(), lane = tid & 63, w = __builtin_amdgcn_readfirstlane(tid >> 6);
    const bool sample = item >= 128; const int it = item & 127;
    const int sq = it >> 4, h = (it >> 1) & 7, j2 = it & 1, dv0 = j2 * 64;
    const int c0 = sample ? 512 + sq : sq * 64, nch = sample ? 1 : 64;
    bf16_t* P = (bf16_t*)(p.ws + WS_P); const bf16_t* WK = (const bf16_t*)(p.ws + WS_WK); const bf16_t* QKb = (const bf16_t*)(p.ws + WS_QK);
    const float* BDEC = (const float*)(p.ws + WS_BDEC); float* SSB = (float*)(p.ws + WS_SSB);
    LAS bf16_t* wk = (LAS bf16_t*)lds;
    LAS bf16_t* qd = (LAS bf16_t*)(lds + 17408);
    LAS bf16_t* kT = (LAS bf16_t*)(lds + 34816);
    LAS bf16_t* qk = (LAS bf16_t*)(lds + 53248);
    LAS bf16_t* uv = (LAS bf16_t*)(lds + 62464);
    LAS bf16_t* ST = (LAS bf16_t*)(lds + 71680);
    LAS bf16_t* uT = (LAS bf16_t*)(lds + 89088);
    f32x4 Sacc[4];
    const int sdk = w * 16 + (lane >> 4) * 4;
#pragma unroll
    for (int nt = 0; nt < 4; ++nt) {
#pragma unroll
        for (int r = 0; r < 4; ++r) Sacc[nt][r] = sample ? p.in[5][((size_t)(sq * 8 + h) * 128 + sdk + r) * 128 + dv0 + nt * 16 + (lane & 15)] : 0.f;
    }
    struct RS { u32x4 rw[2], rq[2], rk[2], rqk, ruv; float bdn; };
    RS RA, RB; RA.bdn = 1.f; RB.bdn = 1.f; float bd = 1.f;
    auto load = [&](int c, RS& R) {
        const int r0 = c * 64, ib = c * 8 + h;
#pragma unroll
        for (int l = 0; l < 2; ++l) { const int idx = tid + l * 512;
            R.rw[l] = *(const u32x4*)(WK + (size_t)ib * 8192 + idx * 8);
            { const int i = idx >> 4, d8 = (idx & 15) * 8; R.rq[l] = *(const u32x4*)(P + PADDR((r0 + i), GQ + h * 128 + d8)); }
            { const int dk = idx >> 3, t8 = (idx & 7) * 8; R.rk[l] = *(const u32x4*)(P + PADDR((r0 + (dk >> 1)), GK + h * 128 + (dk & 1) * 64 + t8)); } }
        R.rqk = *(const u32x4*)(QKb + (size_t)ib * 4096 + tid * 8);
        { const int dvl = tid >> 3, t8 = (tid & 7) * 8; R.ruv = *(const u32x4*)(P + PADDR((r0 + dvl), GV + h * 128 + dv0 + t8)); }
        R.bdn = BDEC[ib];
    };
    auto store = [&](const RS& R) {
#pragma unroll
        for (int l = 0; l < 2; ++l) { const int idx = tid + l * 512;
            *(LAS u32x4*)(wk + (idx >> 4) * 136 + (idx & 15) * 8) = R.rw[l];
            *(LAS u32x4*)(qd + (idx >> 4) * 136 + (idx & 15) * 8) = R.rq[l];
            *(LAS u32x4*)(kT + (idx >> 3) * 72 + (idx & 7) * 8) = R.rk[l]; }
        *(LAS u32x4*)(qk + (tid >> 3) * 72 + (tid & 7) * 8) = R.rqk;
        *(LAS u32x4*)(uv + (tid >> 3) * 72 + (tid & 7) * 8) = R.ruv;
    };
    auto writeST = [&]() {
#pragma unroll
        for (int nt = 0; nt < 4; ++nt) { u32x2 o; o.x = cvt_pk_bf16(Sacc[nt][0], Sacc[nt][1]); o.y = cvt_pk_bf16(Sacc[nt][2], Sacc[nt][3]);
            *(LAS u32x2*)(ST + (nt * 16 + (lane & 15)) * 136 + sdk) = o; }
    };
    load(c0, RA); store(RA); writeST(); bd = RA.bdn;
    if (nch > 1) load(c0 + 1, RB);
    __syncthreads();
    auto step = [&](int n, RS& Rl, const RS& Rs) {
        const int r0 = (c0 + n) * 64;
        if (n + 2 < nch) load(c0 + n + 2, Rl);
        const int mt = w >> 1, tok0 = mt * 16 + (lane >> 4) * 4;
        f32x4 O1[2];
        {
            const int nt0 = (w & 1) * 2;
            bf16x8 aw[4], aq[4], b0[4], b1[4];
#pragma unroll
            for (int k4 = 0; k4 < 4; ++k4) { aw[k4] = ldfrag(wk + mt * 16 * 136, 136, lane, k4 * 32); aq[k4] = ldfrag(qd + mt * 16 * 136, 136, lane, k4 * 32);
                b0[k4] = ldfrag(ST + nt0 * 16 * 136, 136, lane, k4 * 32); b1[k4] = ldfrag(ST + (nt0 + 1) * 16 * 136, 136, lane, k4 * 32); }
            __builtin_amdgcn_sched_barrier(0);
            f32x4 pa0 = {0.f, 0.f, 0.f, 0.f}, pa1 = {0.f, 0.f, 0.f, 0.f}; O1[0] = (f32x4){0.f, 0.f, 0.f, 0.f}; O1[1] = (f32x4){0.f, 0.f, 0.f, 0.f};
#pragma unroll
            for (int k4 = 0; k4 < 4; ++k4) { pa0 = MFMA16(aw[k4], b0[k4], pa0); pa1 = MFMA16(aw[k4], b1[k4], pa1); O1[0] = MFMA16(aq[k4], b0[k4], O1[0]); O1[1] = MFMA16(aq[k4], b1[k4], O1[1]); }
#pragma unroll
            for (int tt = 0; tt < 2; ++tt) { const int dv = (nt0 + tt) * 16 + (lane & 15); const f32x4 pa = tt ? pa1 : pa0;
                const u32x2 uvv = *(const LAS u32x2*)(uv + dv * 72 + tok0);
                float u[4];
                u[0] = bflo(uvv.x) - pa[0]; u[1] = bfhi(uvv.x) - pa[1]; u[2] = bflo(uvv.y) - pa[2]; u[3] = bfhi(uvv.y) - pa[3];
                u32x2 o; o.x = cvt_pk_bf16(u[0], u[1]); o.y = cvt_pk_bf16(u[2], u[3]);
                *(LAS u32x2*)(uT + dv * 72 + tok0) = o; }
        }
        __syncthreads();
        {
            float ssq[4] = {0.f, 0.f, 0.f, 0.f};
            const int nt0 = (w & 1) * 2;
            bf16x8 aqk[2], ak[2], bo[2][2], bu[4][2];
#pragma unroll
            for (int k2 = 0; k2 < 2; ++k2) { aqk[k2] = ldfrag(qk + mt * 16 * 72, 72, lane, k2 * 32); ak[k2] = ldfrag(kT + w * 16 * 72, 72, lane, k2 * 32);
                bo[0][k2] = ldfrag(uT + nt0 * 16 * 72, 72, lane, k2 * 32); bo[1][k2] = ldfrag(uT + (nt0 + 1) * 16 * 72, 72, lane, k2 * 32);
#pragma unroll
                for (int nt = 0; nt < 4; ++nt) bu[nt][k2] = ldfrag(uT + nt * 16 * 72, 72, lane, k2 * 32); }
            __builtin_amdgcn_sched_barrier(0);
#pragma unroll
            for (int nt = 0; nt < 4; ++nt) Sacc[nt] = Sacc[nt] * bd;
#pragma unroll
            for (int k2 = 0; k2 < 2; ++k2) { O1[0] = MFMA16(aqk[k2], bo[0][k2], O1[0]); O1[1] = MFMA16(aqk[k2], bo[1][k2], O1[1]);
#pragma unroll
                for (int nt = 0; nt < 4; ++nt) Sacc[nt] = MFMA16(ak[k2], bu[nt][k2], Sacc[nt]); }
#pragma unroll
            for (int tt = 0; tt < 2; ++tt) { const int nt = nt0 + tt;
                bf16_t* d = P + PADDR((r0 + tok0), GV + h * 128 + dv0 + nt * 16 + (lane & 15));
#pragma unroll
                for (int r = 0; r < 4; ++r) { if (!DRY) d[(size_t)r * PRS] = (bf16_t)f2bf(O1[tt][r]); ssq[r] += O1[tt][r] * O1[tt][r]; } }
#pragma unroll
            for (int r = 0; r < 4; ++r) { const float sacc = row16_sum(ssq[r]);
                if ((lane & 15) == 0) SSB[(size_t)(r0 + tok0 + r) * 32 + h * 4 + j2 * 2 + (w & 1)] = sacc; }
        }
        __syncthreads();
        writeST();
        if (n + 1 < nch) { store(Rs); bd = Rs.bdn; }
        __syncthreads();
    };
    for (int n = 0; n < nch; n += 2) { step(n, RA, RB); if (n + 1 < nch) step(n + 1, RB, RA); }
    float* so = p.out + (sample ? O_SGDNS : O_SGDNP);
#pragma unroll
    for (int nt = 0; nt < 4; ++nt)
#pragma unroll
        for (int r = 0; r < 4; ++r) so[((size_t)(sq * 8 + h) * 128 + sdk + r) * 128 + dv0 + nt * 16 + (lane & 15)] = Sacc[nt][r];
    __syncthreads();
}

DI void phase_final(const Params& p, bool dry) {
    const int tid = laundered_tid(), lane = tid & 63, w = tid >> 6;
    const bf16_t* P = (const bf16_t*)(p.ws + WS_P); const float* mod = (const float*)(p.ws + WS_MOD); const float* gf = p.in[21];
    const int nrow = MP + 128, stride = gridDim.x * 8;
    for (int vr0 = blockIdx.x * 8 + w; vr0 < nrow; vr0 += 2 * stride) {
        f32x4 xv[2][4]; float ss[2]; float* yp[2]; bool on[2];
#pragma unroll
        for (int q = 0; q < 2; ++q) {
            const int vr = vr0 + q * stride; on[q] = vr < nrow;
            int row, b; const float* x;
            if (!on[q]) { row = 0; b = 0; x = p.in[0]; yp[q] = p.out; }
            else if (vr < MP) { row = vr; b = vr >> 12; x = p.in[0] + (size_t)vr * 1024; yp[q] = p.out + O_YP + (size_t)vr * 1024; }
            else { const int k = vr - MP; row = MP + (k >> 4) * 64 + (k & 15); b = 8 + (k >> 4); x = p.in[1] + (size_t)k * 1024; yp[q] = p.out + O_YS + (size_t)k * 1024; }
            const float* gt = mod + (size_t)b * 3072 + 2048;
            float s = 0.f;
#pragma unroll
            for (int i = 0; i < 4; ++i) { const int c = i * 256 + lane * 4;
                const f32x4 xx = *(const f32x4*)(x + c), gg = *(const f32x4*)(gt + c); const u32x2 ov = *(const u32x2*)(P + PADDR(row, QA + c));
                f32x4 r; r[0] = xx[0] + gg[0] * bflo(ov.x); r[1] = xx[1] + gg[1] * bfhi(ov.x); r[2] = xx[2] + gg[2] * bflo(ov.y); r[3] = xx[3] + gg[3] * bfhi(ov.y);
                xv[q][i] = r; s += (r[0] * r[0] + r[1] * r[1]) + (r[2] * r[2] + r[3] * r[3]); }
            ss[q] = s;
        }
#pragma unroll
        for (int q = 0; q < 2; ++q) {
            float s = row16_sum(ss[q]); s += __shfl_xor(s, 16); s += __shfl_xor(s, 32);
            const float rstd = rsqrtf(s * (1.0f / 1024.0f) + EPS);
            if (on[q] && !dry) {
#pragma unroll
                for (int i = 0; i < 4; ++i) { const int c = i * 256 + lane * 4; const f32x4 g = *(const f32x4*)(gf + c); *(f32x4*)(yp[q] + c) = xv[q][i] * rstd * g; }
            }
        }
    }
}

__global__ void __launch_bounds__(NTHR) fwd_megakernel(Params p) {
    extern __shared__ __attribute__((aligned(16))) unsigned char lds_raw[];
    LAS unsigned char* lds = (LAS unsigned char*)lds_raw;
    cg::grid_group grid = cg::this_grid();
    unsigned char* ws = p.ws;
    bf16_t* P = (bf16_t*)(ws + WS_P);
    volatile LAS unsigned* xb_st = (volatile LAS unsigned*)(lds + (LDS_BYTES - 16));
    if (threadIdx.x < 4) xb_st[threadIdx.x] = 0u;
    __syncthreads();
    const XcdBarrier xbar = xcd_barrier_post((unsigned*)(ws + WS_BAR), xb_st);
    {
#if PROBE_DUP == 1
        phase_prep(p, lds);
        xcd_barrier(xbar);
        phase_h(p);
        xcd_barrier(xbar);
        phase_small(p);
        xcd_barrier(xbar);
#endif
        phase_prep(p, lds);
        xcd_barrier(xbar);
        if (p.ph_hi == 777) grid.sync();
        phase_h(p);
        xcd_barrier(xbar);
        {
            phase_small(p);
            gemm_small((const bf16_t*)p.out, 128, (size_t)MT * 128, (const bf16_t*)(ws + WS_W1), 5120, SEpiG1{P, p.out + O_CONVS});
            pg8::Gemm g{(const bf16_t*)p.out, (const bf16_t*)(ws + WS_W1), MP, 5120, 1024, 128, (size_t)MT * 256};
            pg8::StaticOrder S; S.init(MP, 5120, gridDim.x, blockIdx.x);
            EpiG1 E{P, (bf16_t*)(ws + WS_HALO), p.out + O_CONVP, p.out + O_CONVS};
            pg8::gemm_phase(lds, g, S, E);
        }
        xcd_barrier(xbar);
#if PROBE_DUP == 2
        {
            pg8::Gemm g{(const bf16_t*)p.out, (const bf16_t*)(ws + WS_W1), MP, 5120, 1024, 128, (size_t)MT * 256};
            pg8::StaticOrder S; S.init(MP, 5120, gridDim.x, blockIdx.x);
            EpiG1 E{P, (bf16_t*)(ws + WS_HALO), p.out + O_CONVP, p.out + O_CONVS};
            pg8::gemm_phase(lds, g, S, E);
        }
        xcd_barrier(xbar);
#endif


        {
            f32x2 wreg[16]; int wh = -1;
#pragma unroll
            for (int i = 0; i < 16; ++i) wreg[i] = (f32x2){0.f, 0.f};
            {
                u32x4 rawn[11]; bool have = false; float psn[2] = {0.f, 0.f}; bool havep = false;
#pragma unroll
                for (int i = 0; i < 11; ++i) rawn[i] = (u32x4){0u, 0u, 0u, 0u};
                for (int item = blockIdx.x; item < NCH * 8; item += gridDim.x) gdn1_item<false>(p, lds, item, wreg, wh, rawn, have, item + (int)gridDim.x, psn, havep);
            }
            {
                unsigned qn[16], kn[16]; bool have = false;
#pragma unroll
                for (int i = 0; i < 16; ++i) { qn[i] = 0u; kn[i] = 0u; }
                const int first = (int)(((NCH * 8 - (int)blockIdx.x + (int)gridDim.x - 1) / (int)gridDim.x) * (int)gridDim.x + (int)blockIdx.x) - NCH * 8;
                for (int item = first; item < NCH * 4; item += gridDim.x) gla1_item<false>(p, lds, item, qn, kn, have, item + (int)gridDim.x);
            }
        }
        xcd_barrier(xbar);
#if PROBE_DUP == 4
        for (int item = blockIdx.x; item < 512; item += gridDim.x) {
            const int grp = item >> 7, it = item & 127;
            if ((grp & 1) == 0) gdn2_item<true>(p, lds, it + (grp >> 1) * 128); else gla2_item<true>(p, lds, it + (grp >> 1) * 128);
        }
        xcd_barrier(xbar);
#endif
#if PROBE_DUP == 41
        for (int item = blockIdx.x; item < 512; item += gridDim.x) {
            const int grp = item >> 7, it = item & 127;
            if ((grp & 1) == 0) gdn2_item<true>(p, lds, it + (grp >> 1) * 128);
        }
        xcd_barrier(xbar);
#endif
#if PROBE_DUP == 42
        for (int item = blockIdx.x; item < 512; item += gridDim.x) {
            const int grp = item >> 7, it = item & 127;
            if ((grp & 1) == 1) gla2_item<true>(p, lds, it + (grp >> 1) * 128);
        }
        xcd_barrier(xbar);
#endif
        {
            for (int b = blockIdx.x; b < 512; b += gridDim.x) {
                const int rnd = b >> 8, bb = b & 255;
                if (bb < 128) { const int pair = (bb & 7) + 8 * (bb >> 4), j2 = (bb >> 3) & 1; if (rnd == 0) gdn2_item<false>(p, lds, pair * 2 + j2); }
                else { const int b2 = bb - 128, quad = (b2 & 7) + 8 * (b2 >> 5), j4 = (b2 >> 3) & 3; gla2_item<false>(p, lds, quad * 4 + j4 + rnd * 128);
                    if (rnd == 1) { const int pair = (b2 & 7) + 8 * (b2 >> 4), j2 = (b2 >> 3) & 1; gdn2_item<false>(p, lds, pair * 2 + j2 + 128);
                        for (int tj = b2; tj < 1280; tj += 128) transpose_tile(p, lds, tj < 1024 ? 1280 + tj : 2816 + (tj - 1024)); } }
            }
        }
        xcd_barrier(xbar);
#if PROBE_DUP == 5
        {
            pg8::Gemm g{(const bf16_t*)p.out, (const bf16_t*)(ws + WS_W1) + (size_t)5120 * 1024, MP, 4096, 1024, 128, (size_t)MT * 256};
            pg8::StaticOrder S; S.init(MP, 4096, gridDim.x, blockIdx.x);
            EpiG1b E{P, (const float*)(ws + WS_SSA), (const float*)(ws + WS_SSB), p.in[16], p.in[17], p.ph_hi != 777};
            pg8::gemm_phase(lds, g, S, E);
        }
        xcd_barrier(xbar);
#endif
        {
            gemm_small((const bf16_t*)p.out, 128, (size_t)MT * 128, (const bf16_t*)(ws + WS_W1) + (size_t)5120 * 1024, 4096, SEpiG1b{P, (const float*)(ws + WS_SSA), (const float*)(ws + WS_SSB), p.in[16], p.in[17]});
            pg8::Gemm g{(const bf16_t*)p.out, (const bf16_t*)(ws + WS_W1) + (size_t)5120 * 1024, MP, 4096, 1024, 128, (size_t)MT * 256};
            pg8::StaticOrder S; S.init(MP, 4096, gridDim.x, blockIdx.x);
            EpiG1b E{P, (const float*)(ws + WS_SSA), (const float*)(ws + WS_SSB), p.in[16], p.in[17], false};
            pg8::gemm_phase(lds, g, S, E);
        }
        xcd_barrier(xbar);
#if PROBE_DUP == 6
        {
            pg8::Gemm g{P + PADDR(0, VA), (const bf16_t*)(ws + WS_WPA), MP, 1024, 1024, 128, (size_t)MT * 256};
            pg8::StaticOrder S; S.init(MP, 1024, gridDim.x, blockIdx.x);
            EpiMerge<0> E{P, p.ph_hi != 777};
            pg8::gemm_phase(lds, g, S, E);
        }
        {
            pg8::Gemm g{P + PADDR(0, GV), (const bf16_t*)(ws + WS_WPB), MP, 1024, 1024, 128, (size_t)MT * 256};
            pg8::StaticOrder S; S.init(MP, 1024, gridDim.x, blockIdx.x);
            EpiMerge<1> E{P, p.ph_hi != 777};
            pg8::gemm_phase(lds, g, S, E);
        }
        xcd_barrier(xbar);
#endif
        {
            gemm_small(P + PADDR(0, VA), 128, (size_t)MT * 128, (const bf16_t*)(ws + WS_WPA), 1024, SEpiMerge<0>{P});
            pg8::Gemm g{P + PADDR(0, VA), (const bf16_t*)(ws + WS_WPA), MP, 1024, 1024, 128, (size_t)MT * 256};
            pg8::StaticOrder S; S.init(MP, 1024, gridDim.x, blockIdx.x);
            EpiMerge<0> E{P, false};
            pg8::gemm_phase(lds, g, S, E);
        }
        {
            gemm_small(P + PADDR(0, GV), 128, (size_t)MT * 128, (const bf16_t*)(ws + WS_WPB), 1024, SEpiMerge<1>{P});
            pg8::Gemm g{P + PADDR(0, GV), (const bf16_t*)(ws + WS_WPB), MP, 1024, 1024, 128, (size_t)MT * 256};
            pg8::StaticOrder S; S.init(MP, 1024, gridDim.x, blockIdx.x);
            EpiMerge<1> E{P, false};
            pg8::gemm_phase(lds, g, S, E);
        }
        xcd_barrier(xbar);
        {
            gemm_small(P + PADDR(0, GK), 128, (size_t)MT * 128, (const bf16_t*)(ws + WS_WOUT), 1024, SEpiOut{P});
            pg8::Gemm g{P + PADDR(0, GK), (const bf16_t*)(ws + WS_WOUT), MP, 1024, 1024, 128, (size_t)MT * 256};
            pg8::StaticOrder S; S.init(MP, 1024, gridDim.x, blockIdx.x);
            EpiOut E{P};
            pg8::gemm_phase(lds, g, S, E);
        }
        xcd_barrier(xbar);
#if PROBE_DUP == 9
        phase_final(p, p.ph_hi != 777);
        xcd_barrier(xbar);
#endif
#if PROBE_DUP == 8
        {
            pg8::Gemm g{P + PADDR(0, GK), (const bf16_t*)(ws + WS_WOUT), MP, 1024, 1024, 128, (size_t)MT * 256};
            pg8::StaticOrder S; S.init(MP, 1024, gridDim.x, blockIdx.x);
            EpiOut E{P};
            pg8::gemm_phase(lds, g, S, E);
        }
        xcd_barrier(xbar);
#endif
#if PROBE_DUP == 20
        for (int q = 0; q < 10; ++q) xcd_barrier(xbar);
#endif
        phase_final(p, false);
    }
}

extern "C" void kernel_launch(void* const* d_in, const int* in_sizes, int n_in, void* d_out, int out_size, void* d_ws, size_t ws_size, hipStream_t stream) {
    static int grid_blocks = 0;
    if (!grid_blocks) {
        if (ws_size < WS_END || n_in != 22) { fprintf(stderr, "kernel_launch: ws %zu < %zu or n_in %d\n", ws_size, (size_t)WS_END, n_in); grid_blocks = -1; return; }
        int dev = 0, cus = 0, per_cu = 0;
        (void)hipGetDevice(&dev);
        (void)hipDeviceGetAttribute(&cus, hipDeviceAttributeMultiprocessorCount, dev);
        (void)hipFuncSetAttribute((const void*)fwd_megakernel, hipFuncAttributeMaxDynamicSharedMemorySize, LDS_BYTES);
        (void)hipOccupancyMaxActiveBlocksPerMultiprocessor(&per_cu, (const void*)fwd_megakernel, NTHR, LDS_BYTES);
        if (per_cu < 1) per_cu = 1;
        grid_blocks = cus * per_cu;
        (void)hipGetLastError();
    }
    if (grid_blocks < 0) return;
    Params p{};
    for (int i = 0; i < 22; ++i) p.in[i] = (const float*)d_in[i];
    p.out = (float*)d_out; p.ws = (unsigned char*)d_ws;
    p.ph_lo = 0; p.ph_hi = 10;
    (void)hipMemsetAsync((unsigned char*)d_ws + WS_BAR, 0, (size_t)XCD_BAR_WORDS * 4, stream);
    void* args[] = {&p};
    hipError_t e = hipLaunchCooperativeKernel((const void*)fwd_megakernel, dim3(grid_blocks), dim3(NTHR), args, LDS_BYTES, stream);
    if (e != hipSuccess) fprintf(stderr, "cooperative launch failed: %s (grid %d)\n", hipGetErrorString(e), grid_blocks);
}
```
